# Optimizing an MI355X kernel written in HIP

```python
import math
import jax, jax.numpy as jnp
from jax import lax
import numpy as np

D_MODEL = 1024
BATCH = 4
SEQ = 4096
DEPTH = 1
DEC_BATCH = 32
DEC_SEQ = 1
PAST_LEN = 8192
PAGE_SIZE = 128

HEAD_DIM = 64
DIL_GROUPS = ((128, 1), (512, 4), (2048, 16))
N_GROUPS = 3
HEADS_PER_GROUP = 4
N_DIL_HEADS = N_GROUPS * HEADS_PER_GROUP
DIL_WIDTH = N_DIL_HEADS * HEAD_DIM
DIL_OUT = HEADS_PER_GROUP * HEAD_DIM
BLOCK = 128
POOL_WINDOWS = (2, 4, 8, 16)
POOL_GROUP = 128
POOL_WIDTH = POOL_GROUP * len(POOL_WINDOWS)
POOL_STATE = max(POOL_WINDOWS) - 1
MEM_LEN = 256
MEM_HEADS = 4
MEM_HEAD_DIM = 128
MEM_WIDTH = MEM_HEADS * MEM_HEAD_DIM
N_BUCKETS = 32
MAX_DISTANCE = 2048
D_FF = 2816
N_BRANCH = 3
IN_COLS = 3 * DIL_WIDTH + POOL_WIDTH + MEM_WIDTH + N_BRANCH * D_MODEL
EPS = 1e-6
NEG_INF = -1e30

kernel_name = "hybrid_dilated_pool_memory_decoder_step"


def rms_norm(x, g):
    xf = x.astype(jnp.float32)
    xf = xf * lax.rsqrt(jnp.mean(xf * xf, axis=-1, keepdims=True) + EPS)
    return xf.astype(x.dtype) * g


def swiglu(h, wg, wu, wd):
    return (jax.nn.silu(h @ wg) * (h @ wu)) @ wd


def ffn_half(x, g, wg, wu, wd):
    return x + 0.5 * swiglu(rms_norm(x, g), wg, wu, wd)


def rel_bucket(n):
    max_exact = N_BUCKETS // 2
    nf = jnp.maximum(n, 1).astype(jnp.float32)
    large = max_exact + (jnp.log(nf / max_exact) / math.log(MAX_DISTANCE / max_exact)
                         * (N_BUCKETS - max_exact)).astype(jnp.int32)
    large = jnp.minimum(large, N_BUCKETS - 1)
    return jnp.where(n < max_exact, n, large)


def dilation_bias(rel_bias, g, window, dil):
    j = jnp.arange(window // dil + 1, dtype=jnp.int32)
    b = rel_bias[rel_bucket(j * dil)]
    return b[:, g * HEADS_PER_GROUP:(g + 1) * HEADS_PER_GROUP].astype(jnp.float32)


def split_proj(u, w_in_l):
    n, t, _ = u.shape
    p = u @ w_in_l
    o = 3 * DIL_WIDTH
    qkv = p[..., :o].reshape(n, t, 3, N_GROUPS, HEADS_PER_GROUP, HEAD_DIM)
    z = p[..., o:o + POOL_WIDTH]
    o += POOL_WIDTH
    qm = p[..., o:o + MEM_WIDTH].reshape(n, t, MEM_HEADS, MEM_HEAD_DIM)
    o += MEM_WIDTH
    gates = jax.nn.sigmoid(p[..., o:].astype(jnp.float32)).astype(u.dtype)
    return qkv, z, qm, gates.reshape(n, t, N_BRANCH, D_MODEL)


def dilated_prompt(q, k, v, bias_j, dil, window):
    n, s, h, dh = q.shape
    nk = window // dil
    L = s // dil
    nb = -(-L // BLOCK)
    Lp = nb * BLOCK

    def to_blocks(a):
        a = a.reshape(n, L, dil, h, dh).transpose(0, 2, 1, 3, 4)
        a = jnp.pad(a, ((0, 0), (0, 0), (0, Lp - L), (0, 0), (0, 0)))
        return a.reshape(n, dil, nb, BLOCK, h, dh)

    def with_prev(a):
        prev = jnp.concatenate([jnp.zeros_like(a[:, :, :1]), a[:, :, :-1]], axis=2)
        return jnp.concatenate([prev, a], axis=3)

    qb = to_blocks(q)
    kk = with_prev(to_blocks(k))
    vv = with_prev(to_blocks(v))
    scores = jnp.einsum('brnqhd,brnkhd->brnhqk', qb, kk,
                        preferred_element_type=jnp.float32) * (1.0 / math.sqrt(dh))
    qi = jnp.arange(BLOCK)[:, None]
    ki = jnp.arange(2 * BLOCK)[None, :]
    rel = qi + BLOCK - ki
    valid = (rel >= 0) & (rel <= nk)
    key_exists = (jnp.arange(nb)[:, None] > 0) | (ki >= BLOCK)
    bias = bias_j[jnp.clip(rel, 0, nk)].transpose(2, 0, 1)
    mask = valid[None, :, :] & key_exists[:, None, :]
    logits = jnp.where(mask[None, None, :, None], scores + bias, NEG_INF)
    lse = jax.nn.logsumexp(logits, axis=-1)
    pr = jnp.exp(logits - lse[..., None])
    o = jnp.einsum('brnhqk,brnkhd->brnqhd', pr, vv.astype(jnp.float32))
    o = o.reshape(n, dil, Lp, h, dh)[:, :, :L].transpose(0, 2, 1, 3, 4).reshape(n, s, h, dh)
    lse = lse.transpose(0, 1, 2, 4, 3).reshape(n, dil, Lp, h)[:, :, :L]
    lse = lse.transpose(0, 2, 1, 3).reshape(n, s, h)
    return o, lse


def dilated_sample(q, kv_buf, k_new, v_new, bias_j, dil, window):
    wb = kv_buf.shape[1]
    t = q.shape[1]
    kc = jnp.concatenate([kv_buf[:, :, 0], k_new], axis=1)
    vc = jnp.concatenate([kv_buf[:, :, 1], v_new], axis=1)
    nk = window // dil
    idx = wb + jnp.arange(t)[:, None] - dil * jnp.arange(nk + 1)[None, :]
    valid = idx >= 0
    idxc = jnp.maximum(idx, 0)
    kg = kc[:, idxc]
    vg = vc[:, idxc]
    scores = jnp.einsum('nthd,ntjhd->nhtj', q, kg,
                        preferred_element_type=jnp.float32) * (1.0 / math.sqrt(q.shape[-1]))
    logits = jnp.where(valid[None, None], scores + bias_j.T[None, :, None, :], NEG_INF)
    lse = jax.nn.logsumexp(logits, axis=-1)
    pr = jnp.exp(logits - lse[..., None])
    o = jnp.einsum('nhtj,ntjhd->nthd', pr, vg.astype(jnp.float32))
    return o, lse.transpose(0, 2, 1)


def combine_groups(outs, lses):
    o = jnp.stack(outs, axis=2)
    w = jax.nn.softmax(jnp.stack(lses, axis=2), axis=2)
    o = jnp.sum(w[..., None] * o, axis=2)
    return o.reshape(o.shape[0], o.shape[1], DIL_OUT)


def pool_mixer(z_hist, z_new, pos0, w_pool_l, pool_scale_l):
    n, lh, c = z_hist.shape
    t = z_new.shape[1]
    zf = jnp.concatenate([z_hist, z_new], axis=1).astype(jnp.float32)
    c0 = jnp.concatenate([jnp.zeros((n, 1, c), jnp.float32), jnp.cumsum(zf, axis=1)], axis=1)
    r = lh + jnp.arange(t)
    pos = pos0 + jnp.arange(t)
    hi = c0[:, r + 1]
    outs = []
    for gi, kw in enumerate(POOL_WINDOWS):
        sl = slice(gi * POOL_GROUP, (gi + 1) * POOL_GROUP)
        lo = c0[:, jnp.maximum(r + 1 - kw, 0), sl]
        cnt = jnp.minimum(kw, pos + 1).astype(jnp.float32)
        outs.append((hi[..., sl] - lo) / cnt[None, :, None] - zf[:, lh:, sl])
    pooled = jnp.stack(outs, axis=2)
    mixed = jnp.einsum('ntgc,gcd->ntgd', pooled, w_pool_l.astype(jnp.float32)).reshape(n, t, POOL_WIDTH)
    return mixed * pool_scale_l.astype(jnp.float32)


def memory_kv(mem, g_mem_l, w_mem_kv_l):
    n = mem.shape[0]
    return (rms_norm(mem, g_mem_l) @ w_mem_kv_l).reshape(n, MEM_LEN, 2, MEM_HEADS, MEM_HEAD_DIM)


def mem_attend(qm, kv):
    scores = jnp.einsum('nthd,nmhd->nhtm', qm, kv[:, :, 0],
                        preferred_element_type=jnp.float32) * (1.0 / math.sqrt(MEM_HEAD_DIM))
    pr = jax.nn.softmax(scores, axis=-1)
    o = jnp.einsum('nhtm,nmhd->nthd', pr, kv[:, :, 1].astype(jnp.float32))
    return o.reshape(o.shape[0], o.shape[1], MEM_WIDTH)


def merge(a_out, b_out, c_out, gates, w_oa_l, w_ob_l, w_oc_l, w_out_l):
    m = (gates[:, :, 0] * (a_out @ w_oa_l) + gates[:, :, 1] * (b_out @ w_ob_l)
         + gates[:, :, 2] * (c_out @ w_oc_l))
    return m @ w_out_l


def setup_inputs(seed: int = 0) -> dict:
    key = jax.random.key(seed)
    ks = iter(jax.random.split(key, 40))
    f32 = jnp.float32

    def nrm(shape, scale):
        return jax.random.normal(next(ks), shape, f32) * scale

    def gain(shape):
        return 1.0 + nrm(shape, 0.1)

    D = D_MODEL
    inp = {}
    inp["x_prompt"] = nrm((BATCH, SEQ, D), 1.0)
    inp["x_sample"] = nrm((DEC_BATCH, DEC_SEQ, D), 1.0)
    for g, (win, dil) in enumerate(DIL_GROUPS):
        inp["cache_win%d_kv" % g] = nrm((DEPTH, DEC_BATCH, min(win, PAST_LEN), 2, HEADS_PER_GROUP, HEAD_DIM), 1.0)
    inp["state_pool"] = nrm((DEPTH, DEC_BATCH, POOL_STATE, POOL_WIDTH), 1.0)
    inp["cache_mem_kv"] = nrm((DEPTH, DEC_BATCH, MEM_LEN, 2, MEM_HEADS, MEM_HEAD_DIM), 1.0)
    inp["mem_prompt"] = nrm((BATCH, MEM_LEN, D), 1.0)
    inp["rel_bias"] = nrm((N_BUCKETS, N_DIL_HEADS), 0.5)
    inp["g_ffn1"] = gain((DEPTH, D))
    inp["w1_gate"] = nrm((DEPTH, D, D_FF), D ** -0.5)
    inp["w1_up"] = nrm((DEPTH, D, D_FF), D ** -0.5)
    inp["w1_down"] = nrm((DEPTH, D_FF, D), D_FF ** -0.5)
    inp["g_mix"] = gain((DEPTH, D))
    inp["w_in"] = nrm((DEPTH, D, IN_COLS), D ** -0.5)
    inp["w_pool"] = nrm((DEPTH, len(POOL_WINDOWS), POOL_GROUP, POOL_GROUP), POOL_GROUP ** -0.5)
    inp["pool_scale"] = gain((DEPTH, POOL_WIDTH))
    inp["g_mem"] = gain((DEPTH, D))
    inp["w_mem_kv"] = nrm((DEPTH, D, 2 * MEM_WIDTH), D ** -0.5)
    inp["w_oa"] = nrm((DEPTH, DIL_OUT, D), DIL_OUT ** -0.5)
    inp["w_ob"] = nrm((DEPTH, POOL_WIDTH, D), POOL_WIDTH ** -0.5)
    inp["w_oc"] = nrm((DEPTH, MEM_WIDTH, D), MEM_WIDTH ** -0.5)
    inp["w_out"] = nrm((DEPTH, D, D), D ** -0.5)
    inp["g_ffn2"] = gain((DEPTH, D))
    inp["w2_gate"] = nrm((DEPTH, D, D_FF), D ** -0.5)
    inp["w2_up"] = nrm((DEPTH, D, D_FF), D ** -0.5)
    inp["w2_down"] = nrm((DEPTH, D_FF, D), D_FF ** -0.5)
    inp["g_final"] = gain((D,))
    return inp


def reference(x_prompt, x_sample, cache_win0_kv, cache_win1_kv, cache_win2_kv, state_pool, cache_mem_kv,
              mem_prompt, rel_bias, g_ffn1, w1_gate, w1_up, w1_down, g_mix, w_in, w_pool, pool_scale,
              g_mem, w_mem_kv, w_oa, w_ob, w_oc, w_out, g_ffn2, w2_gate, w2_up, w2_down, g_final):
    win_caches = (cache_win0_kv, cache_win1_kv, cache_win2_kv)
    biases = [dilation_bias(rel_bias, g, win, dil) for g, (win, dil) in enumerate(DIL_GROUPS)]

    def block(x, l, mix_fn):
        x = ffn_half(x, g_ffn1[l], w1_gate[l], w1_up[l], w1_down[l])
        u = rms_norm(x, g_mix[l])
        qkv, z, qm, gates = split_proj(u, w_in[l])
        a_out, b_out, c_out, states = mix_fn(qkv, z, qm)
        dt = x.dtype
        x = x + merge(a_out.astype(dt), b_out.astype(dt), c_out.astype(dt), gates,
                      w_oa[l], w_ob[l], w_oc[l], w_out[l])
        x = ffn_half(x, g_ffn2[l], w2_gate[l], w2_up[l], w2_down[l])
        return x, states

    st_p = [[] for _ in range(5)]
    st_s = [[] for _ in range(4)]
    xp = x_prompt
    xs = x_sample
    for l in range(DEPTH):
        def prompt_mix(qkv, z, qm):
            s = qkv.shape[1]
            outs, lses, wins = [], [], []
            for g, (win, dil) in enumerate(DIL_GROUPS):
                q_g, k_g, v_g = qkv[:, :, 0, g], qkv[:, :, 1, g], qkv[:, :, 2, g]
                o, lse = dilated_prompt(q_g, k_g, v_g, biases[g], dil, win)
                outs.append(o)
                lses.append(lse)
                wins.append(jnp.stack([k_g, v_g], axis=2)[:, s - min(win, s):])
            a_out = combine_groups(outs, lses)
            b_out = pool_mixer(z[:, :0], z, 0, w_pool[l], pool_scale[l])
            mkv = memory_kv(mem_prompt, g_mem[l], w_mem_kv[l])
            c_out = mem_attend(qm, mkv)
            return a_out, b_out, c_out, (wins[0], wins[1], wins[2], z[:, s - POOL_STATE:], mkv)

        def sample_mix(qkv, z, qm):
            outs, lses, rows = [], [], []
            for g, (win, dil) in enumerate(DIL_GROUPS):
                q_g, k_g, v_g = qkv[:, :, 0, g], qkv[:, :, 1, g], qkv[:, :, 2, g]
                o, lse = dilated_sample(q_g, win_caches[g][l], k_g, v_g, biases[g], dil, win)
                outs.append(o)
                lses.append(lse)
                rows.append(jnp.stack([k_g, v_g], axis=2))
            a_out = combine_groups(outs, lses)
            b_out = pool_mixer(state_pool[l], z, PAST_LEN, w_pool[l], pool_scale[l])
            c_out = mem_attend(qm, cache_mem_kv[l])
            return a_out, b_out, c_out, (rows[0], rows[1], rows[2], z)

        xp, sp = block(xp, l, prompt_mix)
        xs, ss = block(xs, l, sample_mix)
        for i in range(5):
            st_p[i].append(sp[i])
        for i in range(4):
            st_s[i].append(ss[i])

    y_prompt = rms_norm(xp, g_final)
    y_sample = rms_norm(xs, g_final)
    new_win0_kv_prompt = jnp.stack(st_p[0], axis=0)
    new_win1_kv_prompt = jnp.stack(st_p[1], axis=0)
    new_win2_kv_prompt = jnp.stack(st_p[2], axis=0)
    new_pool_prompt = jnp.stack(st_p[3], axis=0)
    new_mem_kv_prompt = jnp.stack(st_p[4], axis=0)
    new_win0_kv_sample = jnp.stack(st_s[0], axis=0)
    new_win1_kv_sample = jnp.stack(st_s[1], axis=0)
    new_win2_kv_sample = jnp.stack(st_s[2], axis=0)
    new_pool_sample = jnp.stack(st_s[3], axis=0)
    return (y_prompt, y_sample, new_win0_kv_prompt, new_win1_kv_prompt, new_win2_kv_prompt, new_pool_prompt,
            new_mem_kv_prompt, new_win0_kv_sample, new_win1_kv_sample, new_win2_kv_sample, new_pool_sample)
```

```cpp
#include <hip/hip_runtime.h>
#include <cstdio>
#include <cstdint>
#include <cmath>
namespace pg8 {
#define PG8_LAS __attribute__((address_space(3)))
typedef unsigned short bf16_t;
typedef short bf16x8 __attribute__((ext_vector_type(8)));
typedef float f32x4 __attribute__((ext_vector_type(4)));
typedef unsigned u32x4 __attribute__((ext_vector_type(4)));
constexpr int BM = 256, BK = 64, HALF = 128, HTB = HALF * BK * 2  , STAGE_BYTES = 8 * HTB, NXCD = 8, WGM = 8;

__host__ __device__ __forceinline__ int lds_byte(int r, int c) { const int st = (r >> 4) * 2 + (c >> 5), rr = r & 15, cc = c & 31, ob = rr * 64 + cc * 2; return st * 1024 + (ob ^ (((ob >> 9) & 1) << 5)); }
__host__ __device__ __forceinline__ void stage_rc(int b, int& R, int& C) { const int st = b / 1024, sb = b % 1024, swz = sb ^ (((sb >> 9) & 1) << 5); R = (st >> 1) * 16 + swz / 64; C = (st & 1) * 32 + (swz % 64) / 2; }
__host__ __device__ __forceinline__ int perm32(int rho) { const int n = rho >> 4, i = rho & 15; return 8 * (i >> 2) + 4 * n + (i & 3); }

struct Unit { int pm, pn; };
struct Gemm { const bf16_t* A; const bf16_t* Bt; int M, N, K; };

struct StaticOrder {
    int nM, nN, nwg, G, c;
    __host__ __device__ void init(int M, int N, int G_, int c_) { nM = M / BM; nN = N / BM; nwg = nM * nN; G = G_; c = c_; }
    __host__ __device__ bool next(int i, Unit& u) const {
        const long L = (long)i * G + c; if (L >= nwg) return false;
        int wgid = (int)L; { const int q = nwg / NXCD, r = nwg % NXCD, xcd = wgid % NXCD, off = wgid / NXCD; wgid = (xcd < r ? xcd * (q + 1) : r * (q + 1) + (xcd - r) * q) + off; }
        const int nig = WGM * nN, gid = wgid / nig, fm = gid * WGM, gsz = (nM - fm) < WGM ? (nM - fm) : WGM;
        u.pm = fm + ((wgid % nig) % gsz); u.pn = (wgid % nig) / gsz; return true;
    }
    __device__ __forceinline__ void a_ready(const Unit&) const {}
    __device__ __forceinline__ void done(const Unit&) const {}
};

typedef float f32x2_t __attribute__((ext_vector_type(2))); typedef __bf16 bf16x2_t __attribute__((ext_vector_type(2)));
__device__ __forceinline__ unsigned cvt_pk_bf16(float lo, float hi) { const f32x2_t v = {lo, hi}; const bf16x2_t b = __builtin_convertvector(v, bf16x2_t); return __builtin_bit_cast(unsigned, b); }
typedef float f32x2 __attribute__((ext_vector_type(2)));

constexpr int P_MP = 16384, P_MROWS = 16416, P_DFF = 2816;
__device__ __forceinline__ float row_rinv(const float* ssq, int row) { const f32x4 s = *(const f32x4*)(ssq + (size_t)row * 4); return rsqrtf(((s[0] + s[1]) + (s[2] + s[3])) * (1.0f / 1024.0f) + 1e-6f); }
__device__ __forceinline__ float fast_sigmoid(float v) { return __builtin_amdgcn_rcpf(1.0f + __builtin_amdgcn_exp2f(v * -1.4426950408889634f)); }
__device__ __forceinline__ u32x4 pack8(const f32x4 a, const f32x4 b) { u32x4 w; w.x = cvt_pk_bf16(a[0], a[1]); w.y = cvt_pk_bf16(a[2], a[3]); w.z = cvt_pk_bf16(b[0], b[1]); w.w = cvt_pk_bf16(b[2], b[3]); return w; }
__device__ __forceinline__ float bf_lo(unsigned w) { return __uint_as_float(w << 16); }
__device__ __forceinline__ float bf_hi(unsigned w) { return __uint_as_float(w & 0xffff0000u); }

struct EpiGateUp {
    static constexpr bool PERM = true, AFTER_DRAIN = false;
    bf16_t* H; const float* ssq;
    __device__ __forceinline__ void operator()(const f32x4 (&acc)[2][2][4][2], const Unit& u, int wr, int wc, int fr, int fq) const {
        const int row0 = u.pm * BM + wr * 64 + fr, col0 = u.pn * HALF + wc * 32 + 8 * fq;
#pragma unroll
        for (int ai = 0; ai < 2; ++ai)
#pragma unroll
            for (int m = 0; m < 4; ++m) { const int row = row0 + ai * HALF + m * 16; const float ri = row_rinv(ssq, row);
                f32x4 hv[2];
#pragma unroll
                for (int n = 0; n < 2; ++n) { const f32x4 g = acc[ai][0][m][n] * ri, up = acc[ai][1][m][n] * ri;
#pragma unroll
                    for (int j = 0; j < 4; ++j) hv[n][j] = g[j] * fast_sigmoid(g[j]) * up[j]; }
                *(u32x4*)(H + (size_t)row * P_DFF + col0) = pack8(hv[0], hv[1]); }
    }
};

struct EpiWin {
    static constexpr bool PERM = true, AFTER_DRAIN = false;
    bf16_t* QKV; float* Z; bf16_t* QM; bf16_t* G; const float* ssq; float* out;
    static constexpr size_t o_w0p = (size_t)P_MROWS * 1024, o_pp = o_w0p + 262144 + 1048576 + 4194304, o_w0s = o_pp + 30720 + 1048576, o_ps = o_w0s + 3 * 16384;
    __device__ __forceinline__ void operator()(const f32x4 (&acc)[2][2][4][2], const Unit& u, int wr, int wc, int fr, int fq) const {
        const int row0 = u.pm * BM + wr * 64 + fr, pn = u.pn;
#pragma unroll
        for (int ai = 0; ai < 2; ++ai)
#pragma unroll
            for (int m = 0; m < 4; ++m) { const int row = row0 + ai * HALF + m * 16; if (row >= P_MROWS) continue; const float ri = row_rinv(ssq, row);
#pragma unroll
                for (int bj = 0; bj < 2; ++bj) { const int cl = bj * HALF + wc * 32 + 8 * fq;
                    f32x4 v0 = acc[ai][bj][m][0] * ri, v1 = acc[ai][bj][m][1] * ri;
                    if (pn < 9) {
                        if (pn >= 3) {
                            const int g = pn % 3, kv = (pn >= 6) ? 1 : 0, W = (g == 0) ? 128 : (g == 1) ? 512 : 2048; const size_t owp = o_w0p + (g >= 1 ? 262144u : 0u) + (g >= 2 ? 1048576u : 0u), ows = o_w0s + (size_t)g * 16384;
                            float* dst = nullptr;
                            if (row < P_MP) { const int b = row >> 12, t = row & 4095; if (t >= 4096 - W) dst = out + owp + ((size_t)(b * W + (t - (4096 - W))) * 2 + kv) * 256 + cl; }
                            else dst = out + ows + ((size_t)(row - P_MP) * 2 + kv) * 256 + cl;
                            if (dst) { *(f32x4*)dst = v0; *(f32x4*)(dst + 4) = v1; }
                        } else { v0 = v0 * 0.125f; v1 = v1 * 0.125f; }
                        *(u32x4*)(QKV + (size_t)row * 2304 + pn * 256 + cl) = pack8(v0, v1);
                    } else if (pn < 11) {
                        const int c = (pn - 9) * 256 + cl; float* zp = Z + (size_t)row * 512 + c; *(f32x4*)zp = v0; *(f32x4*)(zp + 4) = v1;
                        float* dst = nullptr;
                        if (row < P_MP) { const int b = row >> 12, t = row & 4095; if (t >= 4096 - 15) dst = out + o_pp + (size_t)(b * 15 + (t - (4096 - 15))) * 512 + c; }
                        else dst = out + o_ps + (size_t)(row - P_MP) * 512 + c;
                        if (dst) { *(f32x4*)dst = v0; *(f32x4*)(dst + 4) = v1; }
                    } else if (pn < 13) {
                        const float sc = 0.08838834764831845f; v0 = v0 * sc; v1 = v1 * sc;
                        *(u32x4*)(QM + (size_t)row * 512 + (pn - 11) * 256 + cl) = pack8(v0, v1);
                    } else {
#pragma unroll
                        for (int j = 0; j < 4; ++j) { v0[j] = fast_sigmoid(v0[j]); v1[j] = fast_sigmoid(v1[j]); }
                        *(u32x4*)(G + (size_t)row * 3072 + (pn - 13) * 256 + cl) = pack8(v0, v1);
                    } } }
    }
};

struct EpiMemKV {
    static constexpr bool PERM = true, AFTER_DRAIN = false;
    float* out; bf16_t* KVb; const float* ssq;
    __device__ __forceinline__ void operator()(const f32x4 (&acc)[2][2][4][2], const Unit& u, int wr, int wc, int fr, int fq) const {
        const int row0 = u.pm * BM + wr * 64 + fr;
#pragma unroll
        for (int ai = 0; ai < 2; ++ai)
#pragma unroll
            for (int m = 0; m < 4; ++m) { const int row = row0 + ai * HALF + m * 16; const float ri = row_rinv(ssq, row);
#pragma unroll
                for (int bj = 0; bj < 2; ++bj) { const int col = u.pn * BM + bj * HALF + wc * 32 + 8 * fq; const f32x4 v0 = acc[ai][bj][m][0] * ri, v1 = acc[ai][bj][m][1] * ri;
                    float* dst = out + (size_t)row * 1024 + col; *(f32x4*)dst = v0; *(f32x4*)(dst + 4) = v1;
                    *(u32x4*)(KVb + (size_t)row * 1024 + col) = pack8(v0, v1); } }
    }
};

struct EpiMerge {
    static constexpr bool PERM = true, AFTER_DRAIN = false;
    const bf16_t* G; float* Mf; bf16_t* Mb; int mode;
    __device__ __forceinline__ void operator()(const f32x4 (&acc)[2][2][4][2], const Unit& u, int wr, int wc, int fr, int fq) const {
        const int row0 = u.pm * BM + wr * 64 + fr;
#pragma unroll
        for (int ai = 0; ai < 2; ++ai)
#pragma unroll
            for (int m = 0; m < 4; ++m) { const int row = row0 + ai * HALF + m * 16;
#pragma unroll
                for (int bj = 0; bj < 2; ++bj) { const int col = u.pn * BM + bj * HALF + wc * 32 + 8 * fq;
                    const u32x4 gw = *(const u32x4*)(G + (size_t)row * 3072 + col);
                    f32x4 v0 = acc[ai][bj][m][0], v1 = acc[ai][bj][m][1];
                    v0[0] *= bf_lo(gw.x); v0[1] *= bf_hi(gw.x); v0[2] *= bf_lo(gw.y); v0[3] *= bf_hi(gw.y);
                    v1[0] *= bf_lo(gw.z); v1[1] *= bf_hi(gw.z); v1[2] *= bf_lo(gw.w); v1[3] *= bf_hi(gw.w);
                    float* mp = Mf + (size_t)row * 1024 + col;
                    if (mode > 0) { v0 = v0 + *(const f32x4*)mp; v1 = v1 + *(const f32x4*)(mp + 4); }
                    if (mode < 2) { *(f32x4*)mp = v0; *(f32x4*)(mp + 4) = v1; }
                    else *(u32x4*)(Mb + (size_t)row * 1024 + col) = pack8(v0, v1); } }
    }
};

struct EpiResid {
    static constexpr bool PERM = true, AFTER_DRAIN = true;
    const float* base; float* out; bf16_t* xb; float* ssq_out; float scale;
    __device__ __forceinline__ void fused(f32x4 (&acc)[2][2][4][2], const Unit& u, int wr, int wc, int fr, int fq, PG8_LAS unsigned char* lds, int wid, int lane) const {
        PG8_LAS float* P = (PG8_LAS float*)lds;
        const int row0 = u.pm * BM + wr * 64 + fr;
#pragma unroll
        for (int ai = 0; ai < 2; ++ai)
#pragma unroll
            for (int m = 0; m < 4; ++m) { const int row = row0 + ai * HALF + m * 16; float s = 0.f;
#pragma unroll
                for (int bj = 0; bj < 2; ++bj) { const int col = u.pn * BM + bj * HALF + wc * 32 + 8 * fq; const size_t off = (size_t)row * 1024 + col;
                    const f32x4 v0 = *(const f32x4*)(base + off) + acc[ai][bj][m][0] * scale, v1 = *(const f32x4*)(base + off + 4) + acc[ai][bj][m][1] * scale;
                    *(f32x4*)(out + off) = v0; *(f32x4*)(out + off + 4) = v1; *(u32x4*)(xb + off) = pack8(v0, v1);
                    s += (v0[0] * v0[0] + v0[1] * v0[1]) + (v0[2] * v0[2] + v0[3] * v0[3]) + (v1[0] * v1[0] + v1[1] * v1[1]) + (v1[2] * v1[2] + v1[3] * v1[3]); }
                s += __shfl_xor(s, 16); s += __shfl_xor(s, 32);
                if (fq == 0) P[(ai * HALF + wr * 64 + m * 16 + fr) * 4 + wc] = s; }
        asm volatile("s_waitcnt lgkmcnt(0)" ::: "memory"); __builtin_amdgcn_s_barrier(); asm volatile("" ::: "memory");
        const int tid = wid * 64 + lane;
        if (tid < 256) { const f32x4 p = *(const PG8_LAS f32x4*)(P + tid * 4); ssq_out[(size_t)(u.pm * BM + tid) * 4 + u.pn] = (p[0] + p[1]) + (p[2] + p[3]); }
        asm volatile("s_waitcnt lgkmcnt(0)" ::: "memory"); __builtin_amdgcn_s_barrier(); asm volatile("" ::: "memory");
    }
};
struct TailOrder {
    int first, count, nN, c;
    __device__ bool next(int i, Unit& u) const { const int idx = c - first; if (i != 0 || idx < 0 || idx >= count) return false; u.pm = idx / nN; u.pn = idx % nN; return true; }
    __device__ __forceinline__ void a_ready(const Unit&) const {}
    __device__ __forceinline__ void done(const Unit&) const {}
};
template <class Epi, class Sched, bool ALIGN_EPI = false, bool SP2 = false>
__device__ __forceinline__ void gemm_phase(PG8_LAS unsigned char* lds, const Gemm g, const Sched& S, const Epi& E) {
    int tid_ = threadIdx.x; asm volatile("" : "+v"(tid_));
    const int tid = tid_, wid = __builtin_amdgcn_readfirstlane(tid >> 6), lane = tid & 63, wr = wid >> 2, wc = wid & 3, fr = lane & 15, fq = lane >> 4;
    const int K = g.K, nt = K / BK;
    unsigned voffA[2], voffB[2];
#pragma unroll
    for (int i = 0; i < 2; ++i) { int R, C; stage_rc(tid * 16 + i * 8192, R, C); const int Rb = Epi::PERM ? ((R & ~31) + perm32(R & 31)) : R;
        voffA[i] = (unsigned)(R * K + C) * 2u; voffB[i] = (unsigned)(Rb * K + C) * 2u; }
    const size_t kstep = (size_t)(BK * 2);
    const size_t hstep = (size_t)HALF * K * 2;
    const size_t tstep = 2 * hstep;
    const unsigned ldsw = (unsigned)wid * 1024u;
    const int aoff = lds_byte(wr * 64 + fr, fq * 8), boff = lds_byte(wc * 32 + fr, fq * 8);
#define PG8_SA(b, h) (((b) * 2 + (h)) * HTB)
#define PG8_SB(b, h) ((4 + (b) * 2 + (h)) * HTB)
#define PG8_STAGE(bufoff, gbase, voff) do { _Pragma("unroll") for (int _i = 0; _i < 2; ++_i) \
        __builtin_amdgcn_global_load_lds((const unsigned*)((const char*)(gbase) + (voff)[_i]), (PG8_LAS unsigned*)(lds + (bufoff) + ldsw + _i * 8192), 16, 0, 0); } while (0)
#define PG8_LDA(dst, b, h) do { _Pragma("unroll") for (int m = 0; m < 4; ++m) _Pragma("unroll") for (int k = 0; k < 2; ++k) dst[m][k] = *(const PG8_LAS bf16x8*)(lds + PG8_SA(b, h) + aoff + m * 2048 + k * 1024); } while (0)
#define PG8_LDB(dst, b, h) do { _Pragma("unroll") for (int n = 0; n < 2; ++n) _Pragma("unroll") for (int k = 0; k < 2; ++k) dst[n][k] = *(const PG8_LAS bf16x8*)(lds + PG8_SB(b, h) + boff + n * 2048 + k * 1024); } while (0)
#define PG8_MMA(ai, bj, At, Bt) do { __builtin_amdgcn_s_setprio(1); _Pragma("unroll") for (int m = 0; m < 4; ++m) _Pragma("unroll") for (int n = 0; n < 2; ++n) _Pragma("unroll") for (int k = 0; k < 2; ++k) \
        acc[ai][bj][m][n] = __builtin_amdgcn_mfma_f32_16x16x32_bf16(Bt[n][k], At[m][k], acc[ai][bj][m][n], 0, 0, 0); __builtin_amdgcn_s_setprio(0); } while (0)
#define PG8_WAIT_V(n) asm volatile("s_waitcnt vmcnt(" #n ")" ::: "memory")
#define PG8_WAIT_L(n) asm volatile("s_waitcnt lgkmcnt(" #n ")" ::: "memory")
#define PG8_BAR __builtin_amdgcn_s_barrier()
#define PG8_SCHED __builtin_amdgcn_sched_barrier(0)
    Unit cur, nxt; int ui = 0;
    if (!S.next(0, cur)) return;
    f32x4 acc[2][2][4][2];
#pragma unroll
    for (int a = 0; a < 2; ++a)
#pragma unroll
        for (int b = 0; b < 2; ++b)
#pragma unroll
            for (int m = 0; m < 4; ++m)
#pragma unroll
                for (int n = 0; n < 2; ++n) acc[a][b][m][n] = (f32x4){0.f, 0.f, 0.f, 0.f};
    bf16x8 At[4][2], B0[2][2], B1[2][2];
    const char* cA = (const char*)g.A + (size_t)cur.pm * tstep; const char* cB = (const char*)g.Bt + (size_t)cur.pn * tstep;
    S.a_ready(cur);
    if constexpr (SP2) {
        PG8_STAGE(PG8_SB(0, 0), cB, voffB); PG8_STAGE(PG8_SB(0, 1), cB + hstep, voffB); PG8_STAGE(PG8_SA(0, 0), cA, voffA); PG8_STAGE(PG8_SA(0, 1), cA + hstep, voffA);
        if (wr == 1) PG8_BAR;
        PG8_WAIT_V(2); PG8_BAR;
        PG8_STAGE(PG8_SB(1, 0), cB + kstep, voffB); PG8_STAGE(PG8_SA(1, 0), cA + kstep, voffA); PG8_STAGE(PG8_SB(1, 1), cB + hstep + kstep, voffB);
        PG8_WAIT_V(6); PG8_BAR;
    } else {
        PG8_STAGE(PG8_SB(0, 0), cB, voffB); PG8_STAGE(PG8_SA(0, 0), cA, voffA); PG8_STAGE(PG8_SB(0, 1), cB + hstep, voffB); PG8_STAGE(PG8_SA(0, 1), cA + hstep, voffA);
        if (wr == 1) PG8_BAR;
        PG8_WAIT_V(4); PG8_BAR;
        PG8_STAGE(PG8_SB(1, 0), cB + kstep, voffB); PG8_STAGE(PG8_SA(1, 0), cA + kstep, voffA); PG8_STAGE(PG8_SB(1, 1), cB + hstep + kstep, voffB);
        PG8_WAIT_V(6); PG8_BAR;
    }
    for (;;) {
        const bool has_next = S.next(ui + 1, nxt);
        const char* nA = has_next ? (const char*)g.A + (size_t)nxt.pm * tstep : cA; const char* nB = has_next ? (const char*)g.Bt + (size_t)nxt.pn * tstep : cB;
        for (int t = 0; t < nt; t += 2) {
            const bool last = (t == nt - 2);
            const char* a1 = cA + (size_t)(t + 1) * kstep;
            const char* a2 = last ? nA : cA + (size_t)(t + 2) * kstep; const char* b2 = last ? nB : cB + (size_t)(t + 2) * kstep;
            const char* a3 = a2 + kstep; const char* b3 = b2 + kstep;
            if (last && has_next) S.a_ready(nxt);
            if constexpr (SP2) {
            PG8_LDB(B0, 0, 0); PG8_LDB(B1, 0, 1); PG8_SCHED; PG8_LDA(At, 0, 0); PG8_STAGE(PG8_SA(1, 1), a1 + hstep, voffA);
            PG8_WAIT_V(8); PG8_WAIT_L(0); PG8_BAR; PG8_MMA(0, 0, At, B0); PG8_MMA(0, 1, At, B1); PG8_BAR; PG8_SCHED;
            PG8_LDA(At, 0, 1); PG8_STAGE(PG8_SB(0, 0), b2, voffB); PG8_STAGE(PG8_SB(0, 1), b2 + hstep, voffB); PG8_STAGE(PG8_SA(0, 0), a2, voffA);
            PG8_WAIT_V(8); PG8_WAIT_L(0); PG8_BAR; PG8_MMA(1, 0, At, B0); PG8_MMA(1, 1, At, B1); PG8_BAR; PG8_SCHED;
            PG8_LDB(B0, 1, 0); PG8_LDB(B1, 1, 1); PG8_SCHED; PG8_LDA(At, 1, 0); PG8_STAGE(PG8_SA(0, 1), a2 + hstep, voffA);
            PG8_WAIT_V(8); PG8_WAIT_L(0); PG8_BAR; PG8_MMA(0, 0, At, B0); PG8_MMA(0, 1, At, B1); PG8_BAR; PG8_SCHED;
            PG8_LDA(At, 1, 1); PG8_STAGE(PG8_SB(1, 0), b3, voffB); PG8_STAGE(PG8_SB(1, 1), b3 + hstep, voffB); PG8_STAGE(PG8_SA(1, 0), a3, voffA);
            PG8_WAIT_V(8); PG8_WAIT_L(0); PG8_BAR; PG8_MMA(1, 0, At, B0); PG8_MMA(1, 1, At, B1); PG8_BAR; PG8_SCHED;
            } else {
            PG8_LDB(B0, 0, 0); PG8_SCHED; PG8_LDA(At, 0, 0); PG8_STAGE(PG8_SA(1, 1), a1 + hstep, voffA);
            PG8_WAIT_L(8); PG8_BAR; PG8_WAIT_L(0); PG8_MMA(0, 0, At, B0); PG8_BAR; PG8_SCHED;
            PG8_LDB(B1, 0, 1); PG8_STAGE(PG8_SB(0, 0), b2, voffB);
            PG8_BAR; PG8_WAIT_L(0); PG8_MMA(0, 1, At, B1); PG8_BAR;
            PG8_LDA(At, 0, 1); PG8_STAGE(PG8_SA(0, 0), a2, voffA);
            PG8_BAR; PG8_WAIT_L(0); PG8_MMA(1, 0, At, B0); PG8_BAR; PG8_SCHED;
            PG8_STAGE(PG8_SB(0, 1), b2 + hstep, voffB);
            PG8_WAIT_V(6); PG8_BAR; PG8_MMA(1, 1, At, B1); PG8_BAR;
            PG8_LDB(B0, 1, 0); PG8_SCHED; PG8_LDA(At, 1, 0); PG8_STAGE(PG8_SA(0, 1), a2 + hstep, voffA);
            PG8_WAIT_L(8); PG8_BAR; PG8_WAIT_L(0); PG8_MMA(0, 0, At, B0); PG8_BAR; PG8_SCHED;
            PG8_LDB(B1, 1, 1); PG8_STAGE(PG8_SB(1, 0), b3, voffB);
            PG8_BAR; PG8_WAIT_L(0); PG8_MMA(0, 1, At, B1); PG8_BAR;
            PG8_LDA(At, 1, 1); PG8_STAGE(PG8_SA(1, 0), a3, voffA);
            PG8_BAR; PG8_WAIT_L(0); PG8_MMA(1, 0, At, B0); PG8_BAR; PG8_SCHED;
            PG8_STAGE(PG8_SB(1, 1), b3 + hstep, voffB);
            PG8_WAIT_V(6); PG8_BAR; PG8_MMA(1, 1, At, B1); PG8_BAR;
            }
        }
        if constexpr (ALIGN_EPI) { if (wr == 0) PG8_BAR; }
        if constexpr (!Epi::AFTER_DRAIN) { E(acc, cur, wr, wc, fr, fq); S.done(cur); }
        if (!has_next) break;
#pragma unroll
        for (int a = 0; a < 2; ++a)
#pragma unroll
            for (int b = 0; b < 2; ++b)
#pragma unroll
                for (int m = 0; m < 4; ++m)
#pragma unroll
                    for (int n = 0; n < 2; ++n) acc[a][b][m][n] = (f32x4){0.f, 0.f, 0.f, 0.f};
        cur = nxt; cA = nA; cB = nB; ++ui;
        if constexpr (ALIGN_EPI) { if (wr == 1) PG8_BAR; }
    }
    PG8_WAIT_V(0);
    if constexpr (!ALIGN_EPI) { if (wr == 0) PG8_BAR; }
    PG8_BAR;
    if constexpr (Epi::AFTER_DRAIN) { E.fused(acc, cur, wr, wc, fr, fq, lds, wid, lane); S.done(cur); }
#undef PG8_SA
#undef PG8_SB
#undef PG8_STAGE
#undef PG8_LDA
#undef PG8_LDB
#undef PG8_MMA
#undef PG8_WAIT_V
#undef PG8_WAIT_L
#undef PG8_BAR
#undef PG8_SCHED
}
}
#define GAS __attribute__((address_space(1)))
#define LAS __attribute__((address_space(3)))
typedef unsigned short bf16;
typedef unsigned v4u __attribute__((ext_vector_type(4)));
typedef float f32x4 __attribute__((ext_vector_type(4)));
typedef short bf16x8 __attribute__((ext_vector_type(8)));
typedef GAS unsigned gu32;
typedef GAS unsigned long long gu64;
#define RLX_AGENT __ATOMIC_RELAXED, __HIP_MEMORY_SCOPE_AGENT
#define LDS_WAIT() asm volatile("s_waitcnt lgkmcnt(0)" ::: "memory")
#define VM_WAIT() asm volatile("s_waitcnt vmcnt(0)" ::: "memory")
__device__ __forceinline__ unsigned long long rt() { return __builtin_amdgcn_s_memrealtime(); }
__device__ __forceinline__ unsigned f2bf(float f) { unsigned u = __builtin_bit_cast(unsigned, f); return (u + 0x7fffu + ((u >> 16) & 1u)) >> 16; }
__device__ __forceinline__ unsigned pk2(float lo, float hi) { return f2bf(lo) | (f2bf(hi) << 16); }

#define XB_TMO      128
#define XB_XCNT(j)  (256  + 64 * (j))
#define XB_XSUB(j)  (1280 + 64 * (j))
#define XB_XGEN(j)  (2304 + 64 * (j))
#define XB_TOP      3328
#define XB_TOPGEN   3392
#define XCD_BAR_WORDS 3456
#define XB_SPIN_CAP (1u << 26)

__device__ __forceinline__ unsigned xb_ld(unsigned* p)              { return __hip_atomic_load(p, __ATOMIC_RELAXED, __HIP_MEMORY_SCOPE_AGENT); }
__device__ __forceinline__ unsigned xb_add(unsigned* p, unsigned v) { return __hip_atomic_fetch_add(p, v, __ATOMIC_RELAXED, __HIP_MEMORY_SCOPE_AGENT); }
__device__ __forceinline__ unsigned xb_xcc_id() { return (unsigned)__builtin_amdgcn_s_getreg((3 << 11) | 20) & 0xFu; }
#define XB_SPIN(cond, bar) do { unsigned _sp = 0; while (cond) { __builtin_amdgcn_s_sleep(1); \
    if ((++_sp & 255u) == 0u) { if (xb_ld(&(bar)[XB_TMO])) break; if (_sp > XB_SPIN_CAP) { atomicAdd(&(bar)[XB_TMO], 1u); break; } } } } while (0)

struct XcdBarrier {
    unsigned* bar; unsigned x;
    volatile LAS unsigned* st;
};

__device__ __forceinline__ XcdBarrier xcd_barrier_post(unsigned* bar, volatile LAS unsigned* st) {
    XcdBarrier b; b.bar = bar; b.x = xb_xcc_id(); b.st = st;
    if (threadIdx.x == 0) (void)xb_add(&bar[XB_XCNT(b.x)], 1u);
    return b;
}
__device__ __forceinline__ void xcd_barrier_complete(unsigned* bar, unsigned x, unsigned& nloc, unsigned& nx) {
    const unsigned G = gridDim.x * gridDim.y * gridDim.z;
    unsigned sum, cnt, mine, sp = 0u;
    for (;;) {
        sum = 0u; cnt = 0u; mine = 0u;
#pragma unroll
        for (unsigned j = 0; j < 16; ++j) { const unsigned c = xb_ld(&bar[XB_XCNT(j)]); sum += c; cnt += (c > 0u) ? 1u : 0u; mine = (j == x) ? c : mine; }
        if (sum == G) break;
        __builtin_amdgcn_s_sleep(1);
        if ((++sp & 255u) == 0u) { if (xb_ld(&bar[XB_TMO])) break; if (sp > XB_SPIN_CAP) { atomicAdd(&bar[XB_TMO], 1u); break; } }
    }
    nloc = mine > 0u ? mine : 1u; nx = cnt > 0u ? cnt : 1u;
}

__device__ __forceinline__ void xcd_barrier(const XcdBarrier& b) {
    asm volatile("s_waitcnt vmcnt(0)" ::: "memory");
    __syncthreads();
    if (threadIdx.x == 0) {
        unsigned* bar = b.bar;
        __builtin_amdgcn_s_waitcnt(0);
        unsigned nloc = b.st[0], nx = b.st[1];
        if (nloc == 0u) { xcd_barrier_complete(bar, b.x, nloc, nx); b.st[0] = nloc; b.st[1] = nx; }
        const unsigned old = xb_add(&bar[XB_XSUB(b.x)], 1u);
        const unsigned gen = old / nloc;
        if (old + 1u == (gen + 1u) * nloc) {
            __builtin_amdgcn_fence(__ATOMIC_RELEASE, "agent");
            asm volatile("s_waitcnt vmcnt(0)" ::: "memory");
            const unsigned og = xb_add(&bar[XB_TOP], 1u);
            const unsigned tg = og / nx;
            if (og + 1u == (tg + 1u) * nx) xb_add(&bar[XB_TOPGEN], 1u);
            else XB_SPIN(xb_ld(&bar[XB_TOPGEN]) == tg, bar);
            __builtin_amdgcn_fence(__ATOMIC_ACQUIRE, "agent");
            xb_add(&bar[XB_XGEN(b.x)], 1u);
            asm volatile("s_waitcnt vmcnt(0)" ::: "memory");
        } else {
            XB_SPIN(xb_ld(&bar[XB_XGEN(b.x)]) == gen, bar);
            __builtin_amdgcn_fence(__ATOMIC_ACQUIRE, "agent");
            asm volatile("s_waitcnt vmcnt(0)" ::: "memory");
        }
    }
    __syncthreads();
}

constexpr int NWAVES = 8;
constexpr int D = 1024, NBATCH = 4, SEQ = 4096, MP = NBATCH * SEQ, MS = 32, MROWS = MP + MS, MPAD = 16640;
constexpr int DFF = 2816, INCOLS = 6400;
static_assert(MP == pg8::P_MP && MROWS == pg8::P_MROWS && DFF == pg8::P_DFF, "constants");
constexpr size_t O_W0P = (size_t)MROWS * D, O_W1P = O_W0P + 262144, O_W2P = O_W1P + 1048576, O_PP = O_W2P + 4194304, O_MKV = O_PP + 30720,
                 O_W0S = O_MKV + 1048576, O_W1S = O_W0S + 16384, O_W2S = O_W1S + 16384, O_PS = O_W2S + 16384, O_END = O_PS + 16384;
constexpr size_t MiB = 1u << 20;
constexpr size_t WS_CTL = 0, CTL_ZERO_BYTES = MiB;
constexpr size_t WS_SSQ0 = 1 * MiB, WS_SSQ1 = WS_SSQ0 + 512 * 1024, WS_SSQ2 = 2 * MiB, WS_SSQ3 = WS_SSQ2 + 512 * 1024, WS_SSQM = 3 * MiB, WS_BIAS = WS_SSQM + 256 * 1024;
constexpr size_t WS_W1GU = 4 * MiB, WS_W1D = 15 * MiB, WS_WIN = WS_W1D + 5632 * 1024, WS_WMEM = 33 * MiB, WS_WOA = 35 * MiB, WS_WOB = WS_WOA + 512 * 1024, WS_WOC = WS_WOB + MiB,
                 WS_WOUT = WS_WOC + MiB, WS_W2GU = WS_WOUT + 2 * MiB, WS_W2D = WS_W2GU + 11 * MiB, WS_WPOOL = 56 * MiB;
constexpr size_t WS_AMEM = 57 * MiB, WS_MEMKV = 59 * MiB, WS_XB = 61 * MiB, WS_H = 94 * MiB, WS_QKV = WS_H, WS_QM = WS_QKV + (size_t)MPAD * 2304 * 2, WS_MF = WS_H;
constexpr size_t WS_G = 184 * MiB, WS_Z = 282 * MiB, WS_MB = 315 * MiB, WS_O3 = 315 * MiB, WS_LSE = 364 * MiB, WS_AO = 365 * MiB, WS_BO = 374 * MiB, WS_CO = 391 * MiB, WS_END = 408 * MiB;
static_assert(WS_W1GU + 5632ull * 1024 * 2 <= WS_W1D && WS_W1D + 1024ull * 2816 * 2 <= WS_WIN && WS_WIN + 6400ull * 1024 * 2 <= WS_WMEM && WS_W2D + 1024ull * 2816 * 2 <= WS_WPOOL, "weight map");
static_assert(WS_XB + (size_t)MPAD * 1024 * 2 <= WS_H && WS_H + (size_t)MPAD * 2816 * 2 <= WS_G && WS_QM + (size_t)MPAD * 512 * 2 <= WS_G && WS_MF + (size_t)MPAD * 1024 * 4 <= WS_G, "map 1");
static_assert(WS_G + (size_t)MPAD * 3072 * 2 <= WS_Z && WS_Z + (size_t)MPAD * 512 * 4 <= WS_O3 && WS_MB + (size_t)MPAD * 1024 * 2 <= WS_LSE && WS_O3 + 3ull * MPAD * 256 * 4 <= WS_LSE, "map 2");
static_assert(WS_AO + (size_t)MPAD * 256 * 2 <= WS_BO && WS_BO + (size_t)MPAD * 512 * 2 <= WS_CO && WS_CO + (size_t)MPAD * 512 * 2 <= WS_END, "map 3");
constexpr int CW_BAR = 4096;
constexpr int RING_BYTES = 131072, LDSCTL_OFF = RING_BYTES, MISC_OFF = LDSCTL_OFF + 320, LDS_BYTES = 147456;

struct Args { const float* in[28]; float* out; unsigned char* ws; };

__device__ __forceinline__ float wave_sum(float v) {
#pragma unroll
    for (int o = 1; o < 64; o <<= 1) v += __shfl_xor(v, o);
    return v;
}
__device__ __forceinline__ float wave_max(float v) {
#pragma unroll
    for (int o = 1; o < 64; o <<= 1) v = fmaxf(v, __shfl_xor(v, o));
    return v;
}
__device__ __forceinline__ float bf2f(bf16 v) { return __uint_as_float((unsigned)v << 16); }
__device__ __forceinline__ float blo(unsigned w) { return __uint_as_float(w << 16); }
__device__ __forceinline__ float bhi(unsigned w) { return __uint_as_float(w & 0xffff0000u); }

__device__ __forceinline__ void p0_transpose_item(const float* W, int N, const float* gs, bf16* WT, int Kd, int k0, int n0, int drow0, LAS float* scr, int lane) {
#pragma unroll 8
    for (int i = 0; i < 32; ++i) { const int kk = 2 * i + (lane >> 5); float v = W[(size_t)(k0 + kk) * N + n0 + (lane & 31)]; if (gs) v *= gs[k0 + kk]; scr[kk * 33 + (lane & 31)] = v; }
    LDS_WAIT(); asm volatile("" ::: "memory");
    const int c = lane & 7;
#pragma unroll
    for (int j = 0; j < 4; ++j) { const int n = (lane >> 3) + 8 * j; const LAS float* s = scr + (8 * c) * 33 + n;
        v4u o; o.x = pk2(s[0 * 33], s[1 * 33]); o.y = pk2(s[2 * 33], s[3 * 33]); o.z = pk2(s[4 * 33], s[5 * 33]); o.w = pk2(s[6 * 33], s[7 * 33]);
        *(GAS v4u*)(WT + (size_t)(drow0 + n) * Kd + k0 + 8 * c) = o; }
    LDS_WAIT(); asm volatile("" ::: "memory");
}
__device__ __forceinline__ void p0_matrix_item(const float* W, int K, int N, const float* gs, bf16* WT, int mode, int r, LAS float* scr, int lane) {
    const int nblk = N / 32, kb = r / nblk, nb = r % nblk, n0 = 32 * nb;
    const int drow0 = (mode == 0) ? n0 : ((n0 >> 7) * 256 + (n0 & 127) + (mode == 2 ? 128 : 0));
    p0_transpose_item(W, N, gs, WT, K, 64 * kb, n0, drow0, scr, lane);
}
__device__ __forceinline__ void p0_row(const float* xrow, bf16* orow, float* ssq, int lane) {
    const GAS f32x4* xr = (const GAS f32x4*)xrow + lane;
    f32x4 v[4]; float s = 0.f;
#pragma unroll
    for (int j = 0; j < 4; ++j) { v[j] = xr[64 * j]; s += (v[j].x * v[j].x + v[j].y * v[j].y) + (v[j].z * v[j].z + v[j].w * v[j].w); }
    s = wave_sum(s);
    GAS unsigned long long* o8 = (GAS unsigned long long*)orow + lane;
#pragma unroll
    for (int j = 0; j < 4; ++j) o8[64 * j] = (unsigned long long)pk2(v[j].x, v[j].y) | ((unsigned long long)pk2(v[j].z, v[j].w) << 32);
    if (lane == 0) *(f32x4*)ssq = (f32x4){s, 0.f, 0.f, 0.f};
}

typedef float f32x16 __attribute__((ext_vector_type(16)));
__device__ __forceinline__ void mini_gemm32(LAS unsigned char* lds, const bf16* A, const bf16* Bt, int K, int col0, int wave, int lane) {
    const int ks = K >> 3, k0 = wave * ks;
    const bf16* ap = A + (size_t)(lane & 31) * K + k0 + 8 * (lane >> 5);
    const bf16* bp = Bt + (size_t)(col0 + (lane & 31)) * K + k0 + 8 * (lane >> 5);
    f32x16 acc = {0.f, 0.f, 0.f, 0.f, 0.f, 0.f, 0.f, 0.f, 0.f, 0.f, 0.f, 0.f, 0.f, 0.f, 0.f, 0.f};
#pragma unroll 2
    for (int kk = 0; kk < ks; kk += 16) { const bf16x8 a = *(const bf16x8*)(ap + kk), b = *(const bf16x8*)(bp + kk); acc = __builtin_amdgcn_mfma_f32_32x32x16_bf16(a, b, acc, 0, 0, 0); }
    LAS float* part = (LAS float*)lds;
#pragma unroll
    for (int r = 0; r < 16; ++r) part[(wave * 16 + r) * 64 + lane] = acc[r];
    __syncthreads();
}
__device__ __forceinline__ float mini_elem(LAS unsigned char* lds, int tid, int i, int& row, int& col) {
    const int r = (tid >> 6) + 8 * i, l = tid & 63; const LAS float* part = (const LAS float*)lds; float v = 0.f;
#pragma unroll
    for (int w = 0; w < 8; ++w) v += part[(w * 16 + r) * 64 + l];
    row = (r & 3) + 8 * (r >> 2) + 4 * (l >> 5); col = l & 31; return v;
}
__device__ __forceinline__ float half_sum32(float s) { s += __shfl_xor(s, 1); s += __shfl_xor(s, 2); s += __shfl_xor(s, 4); s += __shfl_xor(s, 8); s += __shfl_xor(s, 16); return s; }
__device__ __forceinline__ void sample_resid(LAS unsigned char* lds, const bf16* A, const bf16* Bt, int K, const float* base, float* out, bf16* xb, float* ssq_out, float scale, int ct, int tid, int wave, int lane) {
    mini_gemm32(lds, A, Bt, K, 32 * ct, wave, lane);
#pragma unroll
    for (int i = 0; i < 2; ++i) { int row, col; const float v = mini_elem(lds, tid, i, row, col); const size_t off = (size_t)row * 1024 + 32 * ct + col;
        const float xn = base[off] + scale * v; out[off] = xn; xb[off] = (bf16)f2bf(xn);
        const float s = half_sum32(xn * xn); if ((lane & 31) == 0) atomicAdd(ssq_out + row * 4 + (ct & 3), s); }
    __syncthreads();
}

__device__ __forceinline__ float dot8(const v4u k, const float* q) {
    return (blo(k.x) * q[0] + bhi(k.x) * q[1]) + (blo(k.y) * q[2] + bhi(k.y) * q[3]) + (blo(k.z) * q[4] + bhi(k.z) * q[5]) + (blo(k.w) * q[6] + bhi(k.w) * q[7]);
}
template <bool SAMPLE>
__device__ __forceinline__ void attn_naive(const Args& args, float* wl  , int task0, int ntask, int tstride, int lane) {
    const bf16* QKV = (const bf16*)(args.ws + WS_QKV); const float* biasT = (const float*)(args.ws + WS_BIAS); bf16* AO = (bf16*)(args.ws + WS_AO);
    float* pbuf = wl; float* qf = wl + 160;
    for (int task = task0; task < ntask; task += tstride) {
        const int mi = task >> 2, h = task & 3; const int m = SAMPLE ? MP + mi : mi; const int t = mi & 4095;
        float lse[3], og[3];
#pragma unroll
        for (int g = 0; g < 3; ++g) {
            const int dil = 1 << (2 * g), W = (g == 0) ? 128 : (g == 1) ? 512 : 2048;
            const float* cache = args.in[2 + g];
            qf[lane] = bf2f(QKV[(size_t)m * 2304 + g * 256 + h * 64 + lane]);
            LDS_WAIT(); asm volatile("" ::: "memory");
            float s[3]; bool val[3];
#pragma unroll
            for (int jj = 0; jj < 3; ++jj) { const int j = lane + 64 * jj; s[jj] = -1e30f;
                val[jj] = (j <= 128) && (SAMPLE || t - dil * j >= 0);
                if (val[jj]) { float d = 0.f;
                    if (!SAMPLE || j == 0) { const bf16* kp = QKV + (size_t)(m - (SAMPLE ? 0 : dil * j)) * 2304 + 768 + g * 256 + h * 64;
#pragma unroll
                        for (int c = 0; c < 8; ++c) d += dot8(*(const v4u*)(kp + 8 * c), qf + 8 * c);
                    } else { const float* kp = cache + ((size_t)(mi * W + (W - dil * j)) * 2 + 0) * 256 + h * 64;
#pragma unroll 8
                        for (int c = 0; c < 64; ++c) d += kp[c] * qf[c]; }
                    s[jj] = d + biasT[(g * 129 + j) * 4 + h]; } }
            const float mx = wave_max(fmaxf(fmaxf(s[0], s[1]), s[2]));
            float ps = 0.f;
#pragma unroll
            for (int jj = 0; jj < 3; ++jj) { const int j = lane + 64 * jj; const float p = val[jj] ? __expf(s[jj] - mx) : 0.f; ps += p; if (j <= 128) pbuf[j] = p; }
            const float sum = wave_sum(ps);
            LDS_WAIT(); asm volatile("" ::: "memory");
            lse[g] = mx + __logf(sum);
            float acc = 0.f;
            const int jmax = SAMPLE ? 128 : ((t >> (2 * g)) < 128 ? (t >> (2 * g)) : 128);
#pragma unroll 8
            for (int j = 0; j <= jmax; ++j) {
                float v;
                if (!SAMPLE || j == 0) v = bf2f(QKV[(size_t)(m - (SAMPLE ? 0 : dil * j)) * 2304 + 1536 + g * 256 + h * 64 + lane]);
                else v = cache[((size_t)(mi * W + (W - dil * j)) * 2 + 1) * 256 + h * 64 + lane];
                acc += pbuf[j] * v; }
            og[g] = acc / sum;
            LDS_WAIT(); asm volatile("" ::: "memory");
        }
        const float mm = fmaxf(fmaxf(lse[0], lse[1]), lse[2]);
        const float w0 = __expf(lse[0] - mm), w1 = __expf(lse[1] - mm), w2 = __expf(lse[2] - mm);
        const float a = (w0 * og[0] + w1 * og[1] + w2 * og[2]) / (w0 + w1 + w2);
        AO[(size_t)m * 256 + h * 64 + lane] = (bf16)f2bf(a);
    }
}
template <bool SAMPLE>
__device__ __forceinline__ void mem_naive(const Args& args, float* wl  , int task0, int ntask, int tstride, int lane) {
    const bf16* QM = (const bf16*)(args.ws + WS_QM); const bf16* KV = (const bf16*)(args.ws + WS_MEMKV); bf16* CO = (bf16*)(args.ws + WS_CO);
    const float* cache = args.in[6];
    float* pbuf = wl; float* qf = wl + 256;
    for (int task = task0; task < ntask; task += tstride) {
        const int mi = task >> 2, h = task & 3; const int m = SAMPLE ? MP + mi : mi; const int b = mi >> 12;
        qf[lane] = bf2f(QM[(size_t)m * 512 + h * 128 + lane]); qf[lane + 64] = bf2f(QM[(size_t)m * 512 + h * 128 + 64 + lane]);
        LDS_WAIT(); asm volatile("" ::: "memory");
        float s[4];
#pragma unroll
        for (int kk = 0; kk < 4; ++kk) { const int key = lane + 64 * kk; float d = 0.f;
            if (!SAMPLE) { const bf16* kp = KV + (size_t)(b * 256 + key) * 1024 + h * 128;
#pragma unroll
                for (int c = 0; c < 16; ++c) d += dot8(*(const v4u*)(kp + 8 * c), qf + 8 * c);
            } else { const float* kp = cache + ((size_t)(mi * 256 + key) * 2 + 0) * 512 + h * 128;
#pragma unroll 8
                for (int c = 0; c < 128; ++c) d += kp[c] * qf[c]; }
            s[kk] = d; }
        const float mx = wave_max(fmaxf(fmaxf(s[0], s[1]), fmaxf(s[2], s[3])));
        float ps = 0.f;
#pragma unroll
        for (int kk = 0; kk < 4; ++kk) { const float p = __expf(s[kk] - mx); ps += p; pbuf[lane + 64 * kk] = p; }
        const float sum = wave_sum(ps);
        LDS_WAIT(); asm volatile("" ::: "memory");
        float a0 = 0.f, a1 = 0.f;
#pragma unroll 8
        for (int key = 0; key < 256; ++key) { const float p = pbuf[key];
            if (!SAMPLE) { const unsigned w = *(const unsigned*)(KV + (size_t)(b * 256 + key) * 1024 + 512 + h * 128 + 2 * lane); a0 += p * blo(w); a1 += p * bhi(w); }
            else { const float* vp = cache + ((size_t)(mi * 256 + key) * 2 + 1) * 512 + h * 128 + 2 * lane; a0 += p * vp[0]; a1 += p * vp[1]; } }
        const float inv = 1.0f / sum;
        *(unsigned*)(CO + (size_t)m * 512 + h * 128 + 2 * lane) = pk2(a0 * inv, a1 * inv);
        LDS_WAIT(); asm volatile("" ::: "memory");
    }
}
template <bool SAMPLE>
__device__ __forceinline__ void pool_naive(const Args& args, float* wl  , int task0, int ntask, int tstride, int lane) {
    const float* Z = (const float*)(args.ws + WS_Z); bf16* BO = (bf16*)(args.ws + WS_BO);
    const float* wpool = args.in[15]; const float* pscale = args.in[16]; const float* state = args.in[5];
    for (int task = task0; task < ntask; task += tstride) {
        const int mi0 = task * 4;
#pragma unroll
        for (int tt = 0; tt < 4; ++tt) { const int mi = mi0 + tt, m = SAMPLE ? MP + mi : mi, t = mi & 4095;
#pragma unroll
            for (int i = 0; i < 8; ++i) { const int c = lane + 64 * i, kw = 2 << (i >> 1); const int cnt = SAMPLE ? kw : ((t + 1 < kw) ? t + 1 : kw);
                const float z0 = Z[(size_t)m * 512 + c]; float sum = z0;
                for (int r = 1; r < cnt; ++r) sum += SAMPLE ? state[(size_t)(mi * 15 + 15 - r) * 512 + c] : Z[(size_t)(m - r) * 512 + c];
                wl[tt * 512 + c] = sum / (float)cnt - z0; } }
        LDS_WAIT(); asm volatile("" ::: "memory");
        for (int gi = 0; gi < 4; ++gi)
            for (int hf = 0; hf < 2; ++hf) { const int d = lane + 64 * hf; float a[4] = {0.f, 0.f, 0.f, 0.f};
#pragma unroll 8
                for (int c = 0; c < 128; ++c) { const float w = wpool[(size_t)(gi * 128 + c) * 128 + d];
#pragma unroll
                    for (int tt = 0; tt < 4; ++tt) a[tt] += wl[tt * 512 + gi * 128 + c] * w; }
                const float sc = pscale[gi * 128 + d];
#pragma unroll
                for (int tt = 0; tt < 4; ++tt) { const int m = (SAMPLE ? MP : 0) + mi0 + tt; BO[(size_t)m * 512 + gi * 128 + d] = (bf16)f2bf(a[tt] * sc); } }
        LDS_WAIT(); asm volatile("" ::: "memory");
    }
}

__global__ void __launch_bounds__(NWAVES * 64, 2) fwd_kernel(Args args) {
    extern __shared__ __attribute__((aligned(16))) unsigned char lds[];
    LAS unsigned char* const L = (LAS unsigned char*)lds;
    volatile LAS unsigned* MISC = (volatile LAS unsigned*)(L + MISC_OFF);
    const int tid = threadIdx.x, lane = tid & 63, wave = __builtin_amdgcn_readfirstlane(tid >> 6);
    const int G = gridDim.x, bx = blockIdx.x;
    const int vcu = (G % 8 == 0) ? (bx % 8) * (G / 8) + bx / 8 : bx;
    unsigned char* const ws = args.ws;
    gu32* ctl = (gu32*)(ws + WS_CTL);
    for (int u = tid; u < (LDS_BYTES - LDSCTL_OFF) / 4; u += NWAVES * 64) ((LAS unsigned*)(L + LDSCTL_OFF))[u] = 0u;
    __syncthreads();
    XcdBarrier bar = xcd_barrier_post((unsigned*)(ctl + CW_BAR), MISC + 8);
#define GRID_BAR() xcd_barrier(bar)
    const int gw = vcu * NWAVES + wave, NGW = G * NWAVES;
    float* const out = args.out;
    float* ssq0 = (float*)(ws + WS_SSQ0); float* ssq1 = (float*)(ws + WS_SSQ1); float* ssq2 = (float*)(ws + WS_SSQ2); float* ssq3 = (float*)(ws + WS_SSQ3); float* ssqm = (float*)(ws + WS_SSQM);
    bf16* XB = (bf16*)(ws + WS_XB); bf16* HB = (bf16*)(ws + WS_H); bf16* GB = (bf16*)(ws + WS_G); float* MF = (float*)(ws + WS_MF); bf16* MB = (bf16*)(ws + WS_MB);

    {
        LAS float* scr = (LAS float*)(L + wave * 16384);
        constexpr int I_GU = 16 * 88, I_D = 44 * 32, I_IN = 16 * 200, I_MEM = 16 * 32, I_OA = 4 * 32, I_OB = 8 * 32, I_OUT = 16 * 32, I_PL = 2 * 4;
        constexpr int NITEMS = 6 * I_GU + I_IN + I_MEM + I_OA + 2 * I_OB + I_OUT + 4 * I_PL;
        static_assert(I_GU == I_D, "items");
        for (int it = gw; it < NITEMS; it += NGW) {
            int r = it;
            if (r < I_GU) { p0_matrix_item(args.in[10], 1024, 2816, args.in[9], (bf16*)(ws + WS_W1GU), 1, r, scr, lane); continue; } r -= I_GU;
            if (r < I_GU) { p0_matrix_item(args.in[11], 1024, 2816, args.in[9], (bf16*)(ws + WS_W1GU), 2, r, scr, lane); continue; } r -= I_GU;
            if (r < I_D) { p0_matrix_item(args.in[12], 2816, 1024, nullptr, (bf16*)(ws + WS_W1D), 0, r, scr, lane); continue; } r -= I_D;
            if (r < I_GU) { p0_matrix_item(args.in[24], 1024, 2816, args.in[23], (bf16*)(ws + WS_W2GU), 1, r, scr, lane); continue; } r -= I_GU;
            if (r < I_GU) { p0_matrix_item(args.in[25], 1024, 2816, args.in[23], (bf16*)(ws + WS_W2GU), 2, r, scr, lane); continue; } r -= I_GU;
            if (r < I_D) { p0_matrix_item(args.in[26], 2816, 1024, nullptr, (bf16*)(ws + WS_W2D), 0, r, scr, lane); continue; } r -= I_D;
            if (r < I_IN) { p0_matrix_item(args.in[14], 1024, 6400, args.in[13], (bf16*)(ws + WS_WIN), 0, r, scr, lane); continue; } r -= I_IN;
            if (r < I_MEM) { p0_matrix_item(args.in[18], 1024, 1024, args.in[17], (bf16*)(ws + WS_WMEM), 0, r, scr, lane); continue; } r -= I_MEM;
            if (r < I_OA) { p0_matrix_item(args.in[19], 256, 1024, nullptr, (bf16*)(ws + WS_WOA), 0, r, scr, lane); continue; } r -= I_OA;
            if (r < I_OB) { p0_matrix_item(args.in[20], 512, 1024, nullptr, (bf16*)(ws + WS_WOB), 0, r, scr, lane); continue; } r -= I_OB;
            if (r < I_OB) { p0_matrix_item(args.in[21], 512, 1024, nullptr, (bf16*)(ws + WS_WOC), 0, r, scr, lane); continue; } r -= I_OB;
            if (r < I_OUT) { p0_matrix_item(args.in[22], 1024, 1024, nullptr, (bf16*)(ws + WS_WOUT), 0, r, scr, lane); continue; } r -= I_OUT;
            { const int g = r / I_PL; p0_matrix_item(args.in[15] + (size_t)g * 16384, 128, 128, nullptr, (bf16*)(ws + WS_WPOOL) + (size_t)g * 16384, 0, r % I_PL, scr, lane); }
        }
        for (int m = gw; m < MPAD + 1024; m += NGW) {
            if (m < MP) p0_row(args.in[0] + (size_t)m * D, XB + (size_t)m * D, ssq0 + (size_t)m * 4, lane);
            else if (m < MROWS) p0_row(args.in[1] + (size_t)(m - MP) * D, XB + (size_t)m * D, ssq0 + (size_t)m * 4, lane);
            else if (m < MPAD) { GAS v4u* o = (GAS v4u*)(XB + (size_t)m * D) + lane; o[0] = (v4u){0u, 0u, 0u, 0u}; o[64] = (v4u){0u, 0u, 0u, 0u};
                if (lane == 0) { *(f32x4*)(ssq0 + (size_t)m * 4) = (f32x4){1024.f, 0.f, 0.f, 0.f}; } }
            else { const int r = m - MPAD; p0_row(args.in[7] + (size_t)r * D, (bf16*)(ws + WS_AMEM) + (size_t)r * D, ssqm + (size_t)r * 4, lane); }
        }
        for (int i = bx * 512 + tid; i < 3 * (MPAD - MP); i += G * 512) { const int k = i / (MPAD - MP), r = MP + i % (MPAD - MP); float* s = (k == 0) ? ssq1 : (k == 1) ? ssq2 : ssq3;
            *(f32x4*)(s + (size_t)r * 4) = (r < MROWS) ? (f32x4){0.f, 0.f, 0.f, 0.f} : (f32x4){1024.f, 0.f, 0.f, 0.f}; }
        for (int i = bx * 512 + tid; i < 3 * 129 * 4; i += G * 512) { const int h = i & 3, j = (i >> 2) % 129, g = (i >> 2) / 129; const int n = j << (2 * g);
            int bk = n; if (n >= 16) { bk = 16 + (int)(log((double)n / 16.0) / log(128.0) * 16.0); if (bk > 31) bk = 31; }
            ((float*)(ws + WS_BIAS))[i] = args.in[8][bk * 12 + g * 4 + h]; }
    }
    GRID_BAR();
#if defined(STOP_AFTER)
    if (STOP_AFTER == 0) return;
#endif

    {
        pg8::Gemm g{XB, (const bf16*)(ws + WS_W1GU), MPAD, 2 * DFF, D}; pg8::StaticOrder S; S.init(MPAD, 2 * DFF, G, bx);
        pg8::EpiGateUp E{HB, ssq0};
        pg8::gemm_phase<pg8::EpiGateUp, pg8::StaticOrder, true, true>(L, g, S, E);
        pg8::Gemm g2{(const bf16*)(ws + WS_AMEM), (const bf16*)(ws + WS_WMEM), 1024, 1024, D}; pg8::TailOrder S2{G - 16, 16, 4, bx};
        pg8::EpiMemKV E2{out + O_MKV, (bf16*)(ws + WS_MEMKV), ssqm};
        pg8::gemm_phase<pg8::EpiMemKV, pg8::TailOrder, true, true>(L, g2, S2, E2);
    }
    GRID_BAR();
#if defined(STOP_AFTER)
    if (STOP_AFTER == 1) return;
#endif

    {
        pg8::Gemm g{HB, (const bf16*)(ws + WS_W1D), MP, D, DFF}; pg8::StaticOrder S; S.init(MP, D, G, bx);
        pg8::EpiResid E{args.in[0], out, XB, ssq1, 0.5f};
        pg8::gemm_phase<pg8::EpiResid, pg8::StaticOrder, false, true>(L, g, S, E);
        if (bx < 32) sample_resid(L, HB + (size_t)MP * DFF, (const bf16*)(ws + WS_W1D), DFF, args.in[1], out + (size_t)MP * D, XB + (size_t)MP * D, ssq1 + (size_t)MP * 4, 0.5f, bx, tid, wave, lane);
    }
    GRID_BAR();
#if defined(STOP_AFTER)
    if (STOP_AFTER == 2) return;
#endif

    {
        pg8::Gemm g{XB, (const bf16*)(ws + WS_WIN), MPAD, INCOLS, D}; pg8::StaticOrder S; S.init(MPAD, INCOLS, G, bx);
        pg8::EpiWin E{(bf16*)(ws + WS_QKV), (float*)(ws + WS_Z), (bf16*)(ws + WS_QM), GB, ssq1, out};
        static_assert(pg8::EpiWin::o_w0p == O_W0P && pg8::EpiWin::o_pp == O_PP && pg8::EpiWin::o_w0s == O_W0S && pg8::EpiWin::o_ps == O_PS, "offsets");
        pg8::gemm_phase<pg8::EpiWin, pg8::StaticOrder, true, true>(L, g, S, E);
    }
    GRID_BAR();
#if defined(STOP_AFTER)
    if (STOP_AFTER == 3) return;
#endif

    {
        float* wl = (float*)(lds + wave * 16384);
#if defined(FAKE_P4)
        { const bf16* QKVs = (const bf16*)(ws + WS_QKV); const bf16* QMs = (const bf16*)(ws + WS_QM); bf16* AO_ = (bf16*)(ws + WS_AO); bf16* BO_ = (bf16*)(ws + WS_BO); bf16* CO_ = (bf16*)(ws + WS_CO);
          for (int m = gw; m < MROWS; m += NGW) { for (int c = lane; c < 256; c += 64) AO_[(size_t)m * 256 + c] = QKVs[(size_t)m * 2304 + 1536 + c];
              for (int c = lane; c < 512; c += 64) { BO_[(size_t)m * 512 + c] = QMs[(size_t)m * 512 + c]; CO_[(size_t)m * 512 + c] = QKVs[(size_t)m * 2304 + 768 + c]; } } }
#else
        attn_naive<false>(args, wl, gw, MP * 4, NGW, lane);
        mem_naive<false>(args, wl, gw, MP * 4, NGW, lane);
        pool_naive<false>(args, wl, gw, MP / 4, NGW, lane);
        const int ts = NGW - 1 - gw;
        if (ts < 128) attn_naive<true>(args, wl, ts, MS * 4, NGW, lane);
        else if (ts < 256) mem_naive<true>(args, wl, ts - 128, MS * 4, NGW, lane);
        else if (ts < 264) pool_naive<true>(args, wl, ts - 256, MS / 4, NGW, lane);
#endif
    }
    GRID_BAR();
#if defined(STOP_AFTER)
    if (STOP_AFTER == 4) return;
#endif

    {
        pg8::StaticOrder S; S.init(MP, D, G, bx);
#if defined(FAKE_P5A)
        for (int m = gw; m < MROWS; m += NGW) for (int c = lane; c < 1024; c += 64) MB[(size_t)m * 1024 + c] = (m < MP) ? GB[(size_t)m * 3072 + c] : XB[(size_t)m * 1024 + c];
#else
        { pg8::Gemm g{(const bf16*)(ws + WS_AO), (const bf16*)(ws + WS_WOA), MP, D, 256}; pg8::EpiMerge E{GB, MF, MB, 0}; pg8::gemm_phase<pg8::EpiMerge, pg8::StaticOrder, false, true>(L, g, S, E); }
        { pg8::Gemm g{(const bf16*)(ws + WS_BO), (const bf16*)(ws + WS_WOB), MP, D, 512}; pg8::EpiMerge E{GB + 1024, MF, MB, 1}; pg8::gemm_phase<pg8::EpiMerge, pg8::StaticOrder, false, true>(L, g, S, E); }
        { pg8::Gemm g{(const bf16*)(ws + WS_CO), (const bf16*)(ws + WS_WOC), MP, D, 512}; pg8::EpiMerge E{GB + 2048, MF, MB, 2}; pg8::gemm_phase<pg8::EpiMerge, pg8::StaticOrder, false, true>(L, g, S, E); }
        if (bx < 32) {
            float mv[2] = {0.f, 0.f};
#pragma unroll
            for (int b = 0; b < 3; ++b) { const int Kb = (b == 0) ? 256 : 512;
                const bf16* A = (const bf16*)(ws + (b == 0 ? WS_AO : b == 1 ? WS_BO : WS_CO)) + (size_t)MP * Kb; const bf16* Bt = (const bf16*)(ws + (b == 0 ? WS_WOA : b == 1 ? WS_WOB : WS_WOC));
                mini_gemm32(L, A, Bt, Kb, 32 * bx, wave, lane);
#pragma unroll
                for (int i = 0; i < 2; ++i) { int row, col; const float v = mini_elem(L, tid, i, row, col); mv[i] += bf2f(GB[(size_t)(MP + row) * 3072 + b * 1024 + 32 * bx + col]) * v; }
                __syncthreads(); }
#pragma unroll
            for (int i = 0; i < 2; ++i) { const int r = (tid >> 6) + 8 * i, l = tid & 63, row = (r & 3) + 8 * (r >> 2) + 4 * (l >> 5), col = l & 31; MB[(size_t)(MP + row) * 1024 + 32 * bx + col] = (bf16)f2bf(mv[i]); }
        }
#endif
    }
    GRID_BAR();
#if defined(STOP_AFTER)
    if (STOP_AFTER == 5) return;
#endif

    {
#if defined(E8)
        pg8::Gemm g{XB, (const bf16*)(ws + WS_WOUT), MP, D, D}; pg8::StaticOrder S; S.init(MP, D, G, bx);
        pg8::EpiResid E{args.in[0], out, (bf16*)(ws + WS_AO), ssq2, 1.0f};
#elif defined(E4)
        pg8::Gemm g{MB, (const bf16*)(ws + WS_WOUT), MP, D, D}; pg8::StaticOrder S; S.init(MP, D, G, bx);
        pg8::EpiResid E{args.in[0], out, (bf16*)(ws + WS_AO), ssq2, 1.0f};
#else
        pg8::Gemm g{MB, (const bf16*)(ws + WS_WOUT), MP, D, D}; pg8::StaticOrder S; S.init(MP, D, G, bx);
        pg8::EpiResid E{out, out, XB, ssq2, 1.0f};
#endif
        pg8::gemm_phase<pg8::EpiResid, pg8::StaticOrder, false, true>(L, g, S, E);
        if (bx < 32) sample_resid(L, MB + (size_t)MP * D, (const bf16*)(ws + WS_WOUT), D, out + (size_t)MP * D, out + (size_t)MP * D, XB + (size_t)MP * D, ssq2 + (size_t)MP * 4, 1.0f, bx, tid, wave, lane);
    }
    GRID_BAR();
#if defined(STOP_AFTER)
    if (STOP_AFTER == 6) return;
#endif

    {
        pg8::Gemm g{XB, (const bf16*)(ws + WS_W2GU), MPAD, 2 * DFF, D}; pg8::StaticOrder S; S.init(MPAD, 2 * DFF, G, bx);
        pg8::EpiGateUp E{HB, ssq2};
        pg8::gemm_phase<pg8::EpiGateUp, pg8::StaticOrder, true, true>(L, g, S, E);
    }
    GRID_BAR();
#if defined(STOP_AFTER)
    if (STOP_AFTER == 7) return;
#endif

    {
        pg8::Gemm g{HB, (const bf16*)(ws + WS_W2D), MP, D, DFF}; pg8::StaticOrder S; S.init(MP, D, G, bx);
        pg8::EpiResid E{out, out, XB, ssq3, 0.5f};
        pg8::gemm_phase<pg8::EpiResid, pg8::StaticOrder, false, true>(L, g, S, E);
        if (bx < 32) sample_resid(L, HB + (size_t)MP * DFF, (const bf16*)(ws + WS_W2D), DFF, out + (size_t)MP * D, out + (size_t)MP * D, XB + (size_t)MP * D, ssq3 + (size_t)MP * 4, 0.5f, bx, tid, wave, lane);
    }
    GRID_BAR();
#if defined(STOP_AFTER)
    if (STOP_AFTER == 8) return;
#endif

    {
        const float* gf = args.in[27];
        for (int m = gw; m < MROWS; m += NGW) { const float ri = pg8::row_rinv(ssq3, m);
            GAS f32x4* xr = (GAS f32x4*)(out + (size_t)m * D) + lane; const GAS f32x4* gr = (const GAS f32x4*)gf + lane;
#pragma unroll
            for (int j = 0; j < 4; ++j) xr[64 * j] = xr[64 * j] * ri * gr[64 * j]; }
    }
}

extern "C" void kernel_launch(void* const* d_in, const int* in_sizes, int n_in, void* d_out, int out_size, void* d_ws, size_t ws_size, hipStream_t stream) {
    static int grid = 0;
    if (grid == 0) {
        if (n_in != 28 || out_size != (int)O_END || ws_size < WS_END) { fprintf(stderr, "kernel_launch: unexpected shapes: n_in %d out %d (want %zu) ws %zu (want %zu)\n", n_in, out_size, (size_t)O_END, ws_size, (size_t)WS_END); grid = -1; return; }
        int dev = 0, cus = 0;
        if (hipGetDevice(&dev) != hipSuccess || hipDeviceGetAttribute(&cus, hipDeviceAttributeMultiprocessorCount, dev) != hipSuccess) { grid = -1; return; }
        if (hipFuncSetAttribute((const void*)fwd_kernel, hipFuncAttributeMaxDynamicSharedMemorySize, LDS_BYTES) != hipSuccess) { fprintf(stderr, "kernel_launch: hipFuncSetAttribute failed\n"); grid = -1; return; }
        int per_cu = 0;
        if (hipOccupancyMaxActiveBlocksPerMultiprocessor(&per_cu, (const void*)fwd_kernel, NWAVES * 64, LDS_BYTES) != hipSuccess || per_cu < 1) fprintf(stderr, "kernel_launch: occupancy query reports %d\n", per_cu);
        (void)hipGetLastError();
        grid = cus;
        if (grid != 256) fprintf(stderr, "kernel_launch: built for 256 CUs, device has %d\n", grid);
    }
    if (grid < 0) return;
    if (hipMemsetAsync((char*)d_ws + WS_CTL, 0, CTL_ZERO_BYTES, stream) != hipSuccess) return;
    Args a{};
    for (int i = 0; i < 28; ++i) a.in[i] = (const float*)d_in[i];
    a.out = (float*)d_out; a.ws = (unsigned char*)d_ws;
    hipLaunchKernelGGL(fwd_kernel, dim3(grid), dim3(NWAVES * 64), LDS_BYTES, stream, a);
}
```

```cpp
#include <hip/hip_runtime.h>
#include <cstdio>
#include <cstdint>
#include <cmath>
namespace pg8 {
#define PG8_LAS __attribute__((address_space(3)))
typedef unsigned short bf16_t;
typedef short bf16x8 __attribute__((ext_vector_type(8)));
typedef float f32x4 __attribute__((ext_vector_type(4)));
typedef unsigned u32x4 __attribute__((ext_vector_type(4)));
constexpr int BM = 256, BK = 64, HALF = 128, HTB = HALF * BK * 2  , STAGE_BYTES = 8 * HTB, NXCD = 8, WGM = 8, AUX_OFF = STAGE_BYTES + 1024;

__host__ __device__ __forceinline__ int lds_byte(int r, int c) { const int st = (r >> 4) * 2 + (c >> 5), rr = r & 15, cc = c & 31, ob = rr * 64 + cc * 2; return st * 1024 + (ob ^ (((ob >> 9) & 1) << 5)); }
__host__ __device__ __forceinline__ void stage_rc(int b, int& R, int& C) { const int st = b / 1024, sb = b % 1024, swz = sb ^ (((sb >> 9) & 1) << 5); R = (st >> 1) * 16 + swz / 64; C = (st & 1) * 32 + (swz % 64) / 2; }
__host__ __device__ __forceinline__ int perm32(int rho) { const int n = rho >> 4, i = rho & 15; return 8 * (i >> 2) + 4 * n + (i & 3); }

struct Unit { int pm, pn; };
struct Gemm { const bf16_t* A; const bf16_t* Bt; int M, N, K; };

struct StaticOrder {
    int nM, nN, nwg, G, c;
    __host__ __device__ void init(int M, int N, int G_, int c_) { nM = M / BM; nN = N / BM; nwg = nM * nN; G = G_; c = c_; }
    __host__ __device__ bool next(int i, Unit& u) const {
        const long L = (long)i * G + c; if (L >= nwg) return false;
        int wgid = (int)L; { const int q = nwg / NXCD, r = nwg % NXCD, xcd = wgid % NXCD, off = wgid / NXCD; wgid = (xcd < r ? xcd * (q + 1) : r * (q + 1) + (xcd - r) * q) + off; }
        const int nig = WGM * nN, gid = wgid / nig, fm = gid * WGM, gsz = (nM - fm) < WGM ? (nM - fm) : WGM;
        u.pm = fm + ((wgid % nig) % gsz); u.pn = (wgid % nig) / gsz; return true;
    }
    __device__ __forceinline__ void a_ready(const Unit&) const {}
    __device__ __forceinline__ void done(const Unit&) const {}
};

typedef float f32x2_t __attribute__((ext_vector_type(2))); typedef __bf16 bf16x2_t __attribute__((ext_vector_type(2)));
__device__ __forceinline__ unsigned cvt_pk_bf16(float lo, float hi) { const f32x2_t v = {lo, hi}; const bf16x2_t b = __builtin_convertvector(v, bf16x2_t); return __builtin_bit_cast(unsigned, b); }
typedef float f32x2 __attribute__((ext_vector_type(2)));

constexpr int P_MP = 16384, P_MROWS = 16416, P_DFF = 2816;
__device__ __forceinline__ float row_rinv(const float* ssq, int row) { const f32x4 s = *(const f32x4*)(ssq + (size_t)row * 4); return rsqrtf(((s[0] + s[1]) + (s[2] + s[3])) * (1.0f / 1024.0f) + 1e-6f); }
__device__ __forceinline__ float aux_rinv(const PG8_LAS unsigned char* aux, int lrow) { const f32x4 s = *(const PG8_LAS f32x4*)(aux + lrow * 16); return rsqrtf(((s[0] + s[1]) + (s[2] + s[3])) * (1.0f / 1024.0f) + 1e-6f); }
__device__ __forceinline__ void prep_ssq(const float* ssq, PG8_LAS unsigned char* aux, const Unit& u, int wid, int lane) {
    if (wid < 4) __builtin_amdgcn_global_load_lds((const unsigned*)(ssq + (size_t)(u.pm * BM + wid * 64 + lane) * 4), (PG8_LAS unsigned*)(aux + wid * 1024), 16, 0, 0);
}
__device__ __forceinline__ float fast_sigmoid(float v) { return __builtin_amdgcn_rcpf(1.0f + __builtin_amdgcn_exp2f(v * -1.4426950408889634f)); }
__device__ __forceinline__ u32x4 pack8(const f32x4 a, const f32x4 b) { u32x4 w; w.x = cvt_pk_bf16(a[0], a[1]); w.y = cvt_pk_bf16(a[2], a[3]); w.z = cvt_pk_bf16(b[0], b[1]); w.w = cvt_pk_bf16(b[2], b[3]); return w; }
typedef unsigned u32x2 __attribute__((ext_vector_type(2)));
__device__ __forceinline__ float u8f(unsigned w, int k) { return (float)((w >> (8 * k)) & 0xffu); }
__device__ __forceinline__ float bf_lo(unsigned w) { return __uint_as_float(w << 16); }
__device__ __forceinline__ float bf_hi(unsigned w) { return __uint_as_float(w & 0xffff0000u); }

struct EpiGateUp {
    static constexpr bool PERM = true, AFTER_DRAIN = false, PREP = true, KHOOK = false;
    bf16_t* H; const float* ssq;
    __device__ __forceinline__ void prep(PG8_LAS unsigned char* aux, const Unit& u, int wid, int lane) const { prep_ssq(ssq, aux, u, wid, lane); }
    __device__ __forceinline__ void operator()(const f32x4 (&acc)[2][2][4][2], const Unit& u, int wr, int wc, int fr, int fq, const PG8_LAS unsigned char* aux) const {
        const int row0 = u.pm * BM + wr * 64 + fr, col0 = u.pn * HALF + wc * 32 + 8 * fq;
#pragma unroll
        for (int ai = 0; ai < 2; ++ai)
#pragma unroll
            for (int m = 0; m < 4; ++m) { const int row = row0 + ai * HALF + m * 16; const float ri = aux_rinv(aux, ai * HALF + wr * 64 + m * 16 + fr);
                f32x4 hv[2];
#pragma unroll
                for (int n = 0; n < 2; ++n) { const f32x4 g = acc[ai][0][m][n] * ri, up = acc[ai][1][m][n] * ri;
#pragma unroll
                    for (int j = 0; j < 4; ++j) hv[n][j] = g[j] * fast_sigmoid(g[j]) * up[j]; }
                *(u32x4*)(H + (size_t)row * P_DFF + col0) = pack8(hv[0], hv[1]); }
    }
};

struct EpiWin {
    static constexpr bool PERM = true, AFTER_DRAIN = false, PREP = true, KHOOK = false;
    bf16_t* QKV; bf16_t* Z; bf16_t* QM; unsigned char* G; const float* ssq; float* out;
    __device__ __forceinline__ void prep(PG8_LAS unsigned char* aux, const Unit& u, int wid, int lane) const { prep_ssq(ssq, aux, u, wid, lane); }
    static constexpr size_t o_w0p = (size_t)P_MROWS * 1024, o_pp = o_w0p + 262144 + 1048576 + 4194304, o_w0s = o_pp + 30720 + 1048576, o_ps = o_w0s + 3 * 16384;
    __device__ __forceinline__ void operator()(const f32x4 (&acc)[2][2][4][2], const Unit& u, int wr, int wc, int fr, int fq, const PG8_LAS unsigned char* aux) const {
        const int row0 = u.pm * BM + wr * 64 + fr, pn = u.pn;
#pragma unroll
        for (int ai = 0; ai < 2; ++ai)
#pragma unroll
            for (int m = 0; m < 4; ++m) { const int row = row0 + ai * HALF + m * 16; if (row >= P_MROWS) continue; const float ri = aux_rinv(aux, ai * HALF + wr * 64 + m * 16 + fr);
#pragma unroll
                for (int bj = 0; bj < 2; ++bj) { const int cl = bj * HALF + wc * 32 + 8 * fq;
                    f32x4 v0 = acc[ai][bj][m][0] * ri, v1 = acc[ai][bj][m][1] * ri;
                    if (pn < 9) {
                        if (pn >= 3) {
                            const int g = pn % 3, kv = (pn >= 6) ? 1 : 0, W = (g == 0) ? 128 : (g == 1) ? 512 : 2048; const size_t owp = o_w0p + (g >= 1 ? 262144u : 0u) + (g >= 2 ? 1048576u : 0u), ows = o_w0s + (size_t)g * 16384;
                            float* dst = nullptr;
                            if (row < P_MP) { const int b = row >> 12, t = row & 4095; if (t >= 4096 - W) dst = out + owp + ((size_t)(b * W + (t - (4096 - W))) * 2 + kv) * 256 + cl; }
                            else dst = out + ows + ((size_t)(row - P_MP) * 2 + kv) * 256 + cl;
                            if (dst) { *(f32x4*)dst = v0; *(f32x4*)(dst + 4) = v1; }
                        } else { v0 = v0 * 0.125f; v1 = v1 * 0.125f; }
                        *(u32x4*)(QKV + (size_t)row * 2304 + pn * 256 + cl) = pack8(v0, v1);
                    } else if (pn < 11) {
                        const int c = (pn - 9) * 256 + cl; *(u32x4*)(Z + (size_t)row * 512 + c) = pack8(v0, v1);
                        float* dst = nullptr;
                        if (row < P_MP) { const int b = row >> 12, t = row & 4095; if (t >= 4096 - 15) dst = out + o_pp + (size_t)(b * 15 + (t - (4096 - 15))) * 512 + c; }
                        else dst = out + o_ps + (size_t)(row - P_MP) * 512 + c;
                        if (dst) { *(f32x4*)dst = v0; *(f32x4*)(dst + 4) = v1; }
                    } else if (pn < 13) {
                        const float sc = 0.08838834764831845f; v0 = v0 * sc; v1 = v1 * sc;
                        *(u32x4*)(QM + (size_t)row * 512 + (pn - 11) * 256 + cl) = pack8(v0, v1);
                    } else {
#pragma unroll
                        for (int j = 0; j < 4; ++j) { v0[j] = fmaxf(fast_sigmoid(v0[j]) * 255.0f + 0.5f, 1.0f); v1[j] = fmaxf(fast_sigmoid(v1[j]) * 255.0f + 0.5f, 1.0f); }
                        u32x2 gb; gb.x = (unsigned)v0[0] | ((unsigned)v0[1] << 8) | ((unsigned)v0[2] << 16) | ((unsigned)v0[3] << 24); gb.y = (unsigned)v1[0] | ((unsigned)v1[1] << 8) | ((unsigned)v1[2] << 16) | ((unsigned)v1[3] << 24);
                        *(u32x2*)(G + (size_t)row * 3072 + (pn - 13) * 256 + cl) = gb;
                    } } }
    }
};

struct EpiMemKV {
    static constexpr bool PERM = true, AFTER_DRAIN = false, PREP = true, KHOOK = false;
    float* out; bf16_t* KVb; const float* ssq;
    __device__ __forceinline__ void prep(PG8_LAS unsigned char* aux, const Unit& u, int wid, int lane) const { prep_ssq(ssq, aux, u, wid, lane); }
    __device__ __forceinline__ void operator()(const f32x4 (&acc)[2][2][4][2], const Unit& u, int wr, int wc, int fr, int fq, const PG8_LAS unsigned char* aux) const {
        const int row0 = u.pm * BM + wr * 64 + fr;
#pragma unroll
        for (int ai = 0; ai < 2; ++ai)
#pragma unroll
            for (int m = 0; m < 4; ++m) { const int row = row0 + ai * HALF + m * 16; const float ri = aux_rinv(aux, ai * HALF + wr * 64 + m * 16 + fr);
#pragma unroll
                for (int bj = 0; bj < 2; ++bj) { const int col = u.pn * BM + bj * HALF + wc * 32 + 8 * fq; const f32x4 v0 = acc[ai][bj][m][0] * ri, v1 = acc[ai][bj][m][1] * ri;
                    float* dst = out + (size_t)row * 1024 + col; *(f32x4*)dst = v0; *(f32x4*)(dst + 4) = v1;
                    *(u32x4*)(KVb + (size_t)row * 1024 + col) = pack8(v0, v1); } }
    }
};

struct EpiMergeH {
    static constexpr bool PERM = true, AFTER_DRAIN = false, PREP = false, KHOOK = true;
    static constexpr int KT1 = 4, KT2 = 12;
    const unsigned char* G; bf16_t* Mb;
    __device__ __forceinline__ void khook(f32x4 (&acc)[2][2][4][2], const Unit& u, int t, int wr, int wc, int fr, int fq) const {
        const unsigned char* Gn = G + (t == KT1 ? 0 : 1024) + (size_t)(u.pm * BM) * 3072 + u.pn * BM;
        const unsigned lo = (unsigned)(wr * 64 + fr) * 3072u + (unsigned)(wc * 32 + 8 * fq);
#pragma unroll
        for (int ai = 0; ai < 2; ++ai)
#pragma unroll
            for (int mh = 0; mh < 2; ++mh) {
                u32x2 gn[2][2], gd[2][2];
#pragma unroll
                for (int mm = 0; mm < 2; ++mm)
#pragma unroll
                    for (int bj = 0; bj < 2; ++bj) { const unsigned o = lo + (unsigned)((ai * HALF + (2 * mh + mm) * 16) * 3072 + bj * HALF); gn[mm][bj] = *(const u32x2*)(Gn + o); gd[mm][bj] = *(const u32x2*)(Gn + 1024 + o); }
                asm volatile("" ::: "memory");
#pragma unroll
                for (int mm = 0; mm < 2; ++mm)
#pragma unroll
                    for (int bj = 0; bj < 2; ++bj) { const u32x2 a = gn[mm][bj], b = gd[mm][bj]; const int m = 2 * mh + mm;
#pragma unroll
                        for (int j = 0; j < 4; ++j) { acc[ai][bj][m][0][j] *= u8f(a.x, j) * __builtin_amdgcn_rcpf(u8f(b.x, j)); acc[ai][bj][m][1][j] *= u8f(a.y, j) * __builtin_amdgcn_rcpf(u8f(b.y, j)); } }
                asm volatile("" ::: "memory");
            }
    }
    __device__ __forceinline__ void operator()(const f32x4 (&acc)[2][2][4][2], const Unit& u, int wr, int wc, int fr, int fq, const PG8_LAS unsigned char*) const {
        const int row0 = u.pm * BM + wr * 64 + fr;
#pragma unroll
        for (int ai = 0; ai < 2; ++ai) {
            u32x2 gw[4][2];
#pragma unroll
            for (int m = 0; m < 4; ++m)
#pragma unroll
                for (int bj = 0; bj < 2; ++bj) gw[m][bj] = *(const u32x2*)(G + 2048 + (size_t)(row0 + ai * HALF + m * 16) * 3072 + u.pn * BM + bj * HALF + wc * 32 + 8 * fq);
            asm volatile("" ::: "memory");
#pragma unroll
            for (int m = 0; m < 4; ++m)
#pragma unroll
                for (int bj = 0; bj < 2; ++bj) { const size_t row = row0 + ai * HALF + m * 16; const int col = u.pn * BM + bj * HALF + wc * 32 + 8 * fq; const u32x2 g = gw[m][bj]; const float k255 = 1.0f / 255.0f;
                    f32x4 v0 = acc[ai][bj][m][0] * k255, v1 = acc[ai][bj][m][1] * k255;
#pragma unroll
                    for (int j = 0; j < 4; ++j) { v0[j] *= u8f(g.x, j); v1[j] *= u8f(g.y, j); }
                    *(u32x4*)(Mb + row * 1024 + col) = pack8(v0, v1); }
            asm volatile("" ::: "memory");
        }
    }
};

__device__ __forceinline__ void unpack8(const u32x4 w, f32x4& a, f32x4& b) { a[0] = bf_lo(w.x); a[1] = bf_hi(w.x); a[2] = bf_lo(w.y); a[3] = bf_hi(w.y); b[0] = bf_lo(w.z); b[1] = bf_hi(w.z); b[2] = bf_lo(w.w); b[3] = bf_hi(w.w); }
template <bool BASE_F32>
struct EpiResid {
    static constexpr bool PERM = true, AFTER_DRAIN = true, PREP = false, KHOOK = false;
    const void* base; bf16_t* xb; float* ssq_out; float scale;
    __device__ __forceinline__ void fused(f32x4 (&acc)[2][2][4][2], const Unit& u, int wr, int wc, int fr, int fq, PG8_LAS unsigned char* lds, int wid, int lane) const {
        PG8_LAS float* P = (PG8_LAS float*)lds;
        const int row0 = u.pm * BM + wr * 64 + fr;
        u32x4 raw[2][4][2];
        if (!BASE_F32) {
#pragma unroll
            for (int ai = 0; ai < 2; ++ai)
#pragma unroll
                for (int m = 0; m < 4; ++m)
#pragma unroll
                    for (int bj = 0; bj < 2; ++bj) raw[ai][m][bj] = *(const u32x4*)((const bf16_t*)base + (size_t)(row0 + ai * HALF + m * 16) * 1024 + u.pn * BM + bj * HALF + wc * 32 + 8 * fq);
            asm volatile("" ::: "memory");
        }
#pragma unroll
        for (int ai = 0; ai < 2; ++ai) {
            f32x4 pre[4][2][2];
#pragma unroll
            for (int m = 0; m < 4; ++m)
#pragma unroll
                for (int bj = 0; bj < 2; ++bj) { const size_t off = (size_t)(row0 + ai * HALF + m * 16) * 1024 + u.pn * BM + bj * HALF + wc * 32 + 8 * fq;
                    if (BASE_F32) { pre[m][bj][0] = *(const f32x4*)((const float*)base + off); pre[m][bj][1] = *(const f32x4*)((const float*)base + off + 4); }
                    else unpack8(raw[ai][m][bj], pre[m][bj][0], pre[m][bj][1]); }
            asm volatile("" ::: "memory");
#pragma unroll
            for (int m = 0; m < 4; ++m) { const int row = row0 + ai * HALF + m * 16; float s = 0.f;
#pragma unroll
                for (int bj = 0; bj < 2; ++bj) { const int col = u.pn * BM + bj * HALF + wc * 32 + 8 * fq; const size_t off = (size_t)row * 1024 + col;
                    const f32x4 v0 = pre[m][bj][0] + acc[ai][bj][m][0] * scale, v1 = pre[m][bj][1] + acc[ai][bj][m][1] * scale;
                    *(u32x4*)(xb + off) = pack8(v0, v1);
                    s += (v0[0] * v0[0] + v0[1] * v0[1]) + (v0[2] * v0[2] + v0[3] * v0[3]) + (v1[0] * v1[0] + v1[1] * v1[1]) + (v1[2] * v1[2] + v1[3] * v1[3]); }
                s += __shfl_xor(s, 16); s += __shfl_xor(s, 32);
                if (fq == 0) P[(ai * HALF + wr * 64 + m * 16 + fr) * 4 + wc] = s; }
            asm volatile("" ::: "memory"); }
        asm volatile("s_waitcnt lgkmcnt(0)" ::: "memory"); __builtin_amdgcn_s_barrier(); asm volatile("" ::: "memory");
        const int tid = wid * 64 + lane;
        if (tid < 256) { const f32x4 p = *(const PG8_LAS f32x4*)(P + tid * 4); ssq_out[(size_t)(u.pm * BM + tid) * 4 + u.pn] = (p[0] + p[1]) + (p[2] + p[3]); }
        asm volatile("s_waitcnt lgkmcnt(0)" ::: "memory"); __builtin_amdgcn_s_barrier(); asm volatile("" ::: "memory");
    }
};
struct EpiFinal {
    static constexpr bool PERM = true, AFTER_DRAIN = true, PREP = false, KHOOK = false;
    const bf16_t* base; float* out; const float* gfin; float* xbuf; unsigned* cnt; float scale;
    __device__ __forceinline__ void fused(f32x4 (&acc)[2][2][4][2], const Unit& u, int wr, int wc, int fr, int fq, PG8_LAS unsigned char* lds, int wid, int lane) const {
        PG8_LAS float* P = (PG8_LAS float*)lds;
        PG8_LAS float* S = (PG8_LAS float*)(lds + 4096);
        const int row0 = u.pm * BM + wr * 64 + fr;
#pragma unroll
        for (int ai = 0; ai < 2; ++ai) {
            f32x4 pre[4][2][2];
#pragma unroll
            for (int m = 0; m < 4; ++m)
#pragma unroll
                for (int bj = 0; bj < 2; ++bj) { const size_t off = (size_t)(row0 + ai * HALF + m * 16) * 1024 + u.pn * BM + bj * HALF + wc * 32 + 8 * fq; unpack8(*(const u32x4*)(base + off), pre[m][bj][0], pre[m][bj][1]); }
            asm volatile("" ::: "memory");
#pragma unroll
            for (int m = 0; m < 4; ++m) { const int row = row0 + ai * HALF + m * 16; float s = 0.f; (void)row;
#pragma unroll
                for (int bj = 0; bj < 2; ++bj) {
                    const f32x4 v0 = pre[m][bj][0] + acc[ai][bj][m][0] * scale, v1 = pre[m][bj][1] + acc[ai][bj][m][1] * scale;
                    acc[ai][bj][m][0] = v0; acc[ai][bj][m][1] = v1;
                    s += (v0[0] * v0[0] + v0[1] * v0[1]) + (v0[2] * v0[2] + v0[3] * v0[3]) + (v1[0] * v1[0] + v1[1] * v1[1]) + (v1[2] * v1[2] + v1[3] * v1[3]); }
                s += __shfl_xor(s, 16); s += __shfl_xor(s, 32);
                if (fq == 0) P[(ai * HALF + wr * 64 + m * 16 + fr) * 4 + wc] = s; }
            asm volatile("" ::: "memory"); }
        asm volatile("s_waitcnt lgkmcnt(0)" ::: "memory"); __builtin_amdgcn_s_barrier(); asm volatile("" ::: "memory");
        const int tid = wid * 64 + lane;
        if (tid < 256) { const f32x4 p = *(const PG8_LAS f32x4*)(P + tid * 4);
            __hip_atomic_store(xbuf + (size_t)(u.pm * BM + tid) * 4 + u.pn, (p[0] + p[1]) + (p[2] + p[3]), __ATOMIC_RELAXED, __HIP_MEMORY_SCOPE_AGENT); }
        asm volatile("s_waitcnt vmcnt(0)" ::: "memory");
        if (lane == 0) __hip_atomic_fetch_add(cnt + 64 * u.pm, 1u, __ATOMIC_RELAXED, __HIP_MEMORY_SCOPE_AGENT);
        if (wid == 0) {
            unsigned sp = 0;
            while ((unsigned)__builtin_amdgcn_readfirstlane(__hip_atomic_load(cnt + 64 * u.pm, __ATOMIC_RELAXED, __HIP_MEMORY_SCOPE_AGENT)) < 32u) { __builtin_amdgcn_s_sleep(1); if (++sp > (1u << 24)) break; }
        }
        asm volatile("s_waitcnt vmcnt(0) lgkmcnt(0)" ::: "memory"); __builtin_amdgcn_s_barrier(); asm volatile("" ::: "memory");
        if (tid < 256) { const float* xp = xbuf + (size_t)(u.pm * BM + tid) * 4;
            const float a = __hip_atomic_load(xp, __ATOMIC_RELAXED, __HIP_MEMORY_SCOPE_AGENT), b = __hip_atomic_load(xp + 1, __ATOMIC_RELAXED, __HIP_MEMORY_SCOPE_AGENT),
                        c = __hip_atomic_load(xp + 2, __ATOMIC_RELAXED, __HIP_MEMORY_SCOPE_AGENT), d = __hip_atomic_load(xp + 3, __ATOMIC_RELAXED, __HIP_MEMORY_SCOPE_AGENT);
            S[tid] = rsqrtf(((a + b) + (c + d)) * (1.0f / 1024.0f) + 1e-6f); }
        asm volatile("s_waitcnt vmcnt(0) lgkmcnt(0)" ::: "memory"); __builtin_amdgcn_s_barrier(); asm volatile("" ::: "memory");
#pragma unroll
        for (int bj = 0; bj < 2; ++bj) { const int col = u.pn * BM + bj * HALF + wc * 32 + 8 * fq; const f32x4 g0 = *(const f32x4*)(gfin + col), g1 = *(const f32x4*)(gfin + col + 4);
#pragma unroll
            for (int ai = 0; ai < 2; ++ai)
#pragma unroll
                for (int m = 0; m < 4; ++m) { const int lr = ai * HALF + wr * 64 + m * 16 + fr; const float ri = S[lr]; const size_t off = (size_t)(u.pm * BM + lr) * 1024 + col;
                    *(f32x4*)(out + off) = acc[ai][bj][m][0] * ri * g0; *(f32x4*)(out + off + 4) = acc[ai][bj][m][1] * ri * g1; } }
        asm volatile("s_waitcnt lgkmcnt(0)" ::: "memory"); __builtin_amdgcn_s_barrier(); asm volatile("" ::: "memory");
    }
};
struct TailOrder {
    int first, count, nN, c;
    __device__ bool next(int i, Unit& u) const { const int idx = c - first; if (i != 0 || idx < 0 || idx >= count) return false; u.pm = idx / nN; u.pn = idx % nN; return true; }
    __device__ __forceinline__ void a_ready(const Unit&) const {}
    __device__ __forceinline__ void done(const Unit&) const {}
};

struct GatedOrder : StaticOrder {
    const unsigned* cnt; unsigned need; int gate_pm;
    __device__ __forceinline__ void a_ready(const Unit& u) const {
        if (u.pm != gate_pm) return;
        if (threadIdx.x < 64) {
            unsigned sp = 0;
            while ((unsigned)__builtin_amdgcn_readfirstlane(__hip_atomic_load(cnt, __ATOMIC_RELAXED, __HIP_MEMORY_SCOPE_AGENT)) < need) { __builtin_amdgcn_s_sleep(2); if (++sp > (1u << 24)) break; }
            __builtin_amdgcn_fence(__ATOMIC_ACQUIRE, "agent");
            asm volatile("s_waitcnt vmcnt(0)" ::: "memory");
        }
        asm volatile("" ::: "memory"); __builtin_amdgcn_s_barrier(); asm volatile("" ::: "memory");
    }
};
template <class Epi, class Sched, bool ALIGN_EPI = false, bool SP2 = false>
__device__ __forceinline__ void gemm_phase(PG8_LAS unsigned char* lds, const Gemm g, const Sched& S, const Epi& E) {
    int tid_ = threadIdx.x; asm volatile("" : "+v"(tid_));
    const int tid = tid_, wid = __builtin_amdgcn_readfirstlane(tid >> 6), lane = tid & 63, wr = wid >> 2, wc = wid & 3, fr = lane & 15, fq = lane >> 4;
    const int K = g.K, nt = K / BK;
    unsigned voffA[2], voffB[2];
#pragma unroll
    for (int i = 0; i < 2; ++i) { int R, C; stage_rc(tid * 16 + i * 8192, R, C); const int Rb = Epi::PERM ? ((R & ~31) + perm32(R & 31)) : R;
        voffA[i] = (unsigned)(R * K + C) * 2u; voffB[i] = (unsigned)(Rb * K + C) * 2u; }
    const size_t kstep = (size_t)(BK * 2);
    const size_t hstep = (size_t)HALF * K * 2;
    const size_t tstep = 2 * hstep;
    const unsigned ldsw = (unsigned)wid * 1024u;
    const int aoff = lds_byte(wr * 64 + fr, fq * 8), boff = lds_byte(wc * 32 + fr, fq * 8);
#define PG8_SA(b, h) (((b) * 2 + (h)) * HTB)
#define PG8_SB(b, h) ((4 + (b) * 2 + (h)) * HTB)
#define PG8_STAGE(bufoff, gbase, voff) do { _Pragma("unroll") for (int _i = 0; _i < 2; ++_i) \
        __builtin_amdgcn_global_load_lds((const unsigned*)((const char*)(gbase) + (voff)[_i]), (PG8_LAS unsigned*)(lds + (bufoff) + ldsw + _i * 8192), 16, 0, 0); } while (0)
#define PG8_LDA(dst, b, h) do { _Pragma("unroll") for (int m = 0; m < 4; ++m) _Pragma("unroll") for (int k = 0; k < 2; ++k) dst[m][k] = *(const PG8_LAS bf16x8*)(lds + PG8_SA(b, h) + aoff + m * 2048 + k * 1024); } while (0)
#define PG8_LDB(dst, b, h) do { _Pragma("unroll") for (int n = 0; n < 2; ++n) _Pragma("unroll") for (int k = 0; k < 2; ++k) dst[n][k] = *(const PG8_LAS bf16x8*)(lds + PG8_SB(b, h) + boff + n * 2048 + k * 1024); } while (0)
#define PG8_MMA(ai, bj, At, Bt) do { __builtin_amdgcn_s_setprio(1); _Pragma("unroll") for (int m = 0; m < 4; ++m) _Pragma("unroll") for (int n = 0; n < 2; ++n) _Pragma("unroll") for (int k = 0; k < 2; ++k) \
        acc[ai][bj][m][n] = __builtin_amdgcn_mfma_f32_16x16x32_bf16(Bt[n][k], At[m][k], acc[ai][bj][m][n], 0, 0, 0); __builtin_amdgcn_s_setprio(0); } while (0)
#define PG8_WAIT_V(n) asm volatile("s_waitcnt vmcnt(" #n ")" ::: "memory")
#define PG8_WAIT_L(n) asm volatile("s_waitcnt lgkmcnt(" #n ")" ::: "memory")
#define PG8_BAR __builtin_amdgcn_s_barrier()
#define PG8_SCHED __builtin_amdgcn_sched_barrier(0)
    Unit cur, nxt; int ui = 0;
    if (!S.next(0, cur)) return;
    f32x4 acc[2][2][4][2];
#pragma unroll
    for (int a = 0; a < 2; ++a)
#pragma unroll
        for (int b = 0; b < 2; ++b)
#pragma unroll
            for (int m = 0; m < 4; ++m)
#pragma unroll
                for (int n = 0; n < 2; ++n) acc[a][b][m][n] = (f32x4){0.f, 0.f, 0.f, 0.f};
    bf16x8 At[4][2], B0[2][2], B1[2][2];
    const char* cA = (const char*)g.A + (size_t)cur.pm * tstep; const char* cB = (const char*)g.Bt + (size_t)cur.pn * tstep;
    S.a_ready(cur);
    PG8_LAS unsigned char* const auxb = lds + AUX_OFF;
    if constexpr (Epi::PREP) E.prep(auxb, cur, wid, lane);
    if constexpr (SP2) {
        PG8_STAGE(PG8_SB(0, 0), cB, voffB); PG8_STAGE(PG8_SB(0, 1), cB + hstep, voffB); PG8_STAGE(PG8_SA(0, 0), cA, voffA); PG8_STAGE(PG8_SA(0, 1), cA + hstep, voffA);
        if (wr == 1) PG8_BAR;
        PG8_WAIT_V(2); PG8_BAR;
        PG8_STAGE(PG8_SB(1, 0), cB + kstep, voffB); PG8_STAGE(PG8_SA(1, 0), cA + kstep, voffA); PG8_STAGE(PG8_SB(1, 1), cB + hstep + kstep, voffB);
        PG8_WAIT_V(6); PG8_BAR;
    } else {
        PG8_STAGE(PG8_SB(0, 0), cB, voffB); PG8_STAGE(PG8_SA(0, 0), cA, voffA); PG8_STAGE(PG8_SB(0, 1), cB + hstep, voffB); PG8_STAGE(PG8_SA(0, 1), cA + hstep, voffA);
        if (wr == 1) PG8_BAR;
        PG8_WAIT_V(4); PG8_BAR;
        PG8_STAGE(PG8_SB(1, 0), cB + kstep, voffB); PG8_STAGE(PG8_SA(1, 0), cA + kstep, voffA); PG8_STAGE(PG8_SB(1, 1), cB + hstep + kstep, voffB);
        PG8_WAIT_V(6); PG8_BAR;
    }
    for (;;) {
        const bool has_next = S.next(ui + 1, nxt);
        const char* nA = has_next ? (const char*)g.A + (size_t)nxt.pm * tstep : cA; const char* nB = has_next ? (const char*)g.Bt + (size_t)nxt.pn * tstep : cB;
        for (int t = 0; t < nt; t += 2) {
            const bool last = (t == nt - 2);
            if constexpr (Epi::KHOOK) { if (t == Epi::KT1 || t == Epi::KT2) E.khook(acc, cur, t, wr, wc, fr, fq); }
            const char* a1 = cA + (size_t)(t + 1) * kstep;
            const char* a2 = last ? nA : cA + (size_t)(t + 2) * kstep; const char* b2 = last ? nB : cB + (size_t)(t + 2) * kstep;
            const char* a3 = a2 + kstep; const char* b3 = b2 + kstep;
            if (last && has_next) S.a_ready(nxt);
            if constexpr (SP2) {
            PG8_LDB(B0, 0, 0); PG8_LDB(B1, 0, 1); PG8_SCHED; PG8_LDA(At, 0, 0); PG8_STAGE(PG8_SA(1, 1), a1 + hstep, voffA);
            PG8_WAIT_V(8); PG8_WAIT_L(0); PG8_BAR; PG8_MMA(0, 0, At, B0); PG8_MMA(0, 1, At, B1); PG8_BAR; PG8_SCHED;
            PG8_LDA(At, 0, 1); PG8_STAGE(PG8_SB(0, 0), b2, voffB); PG8_STAGE(PG8_SB(0, 1), b2 + hstep, voffB); PG8_STAGE(PG8_SA(0, 0), a2, voffA);
            PG8_WAIT_V(8); PG8_WAIT_L(0); PG8_BAR; PG8_MMA(1, 0, At, B0); PG8_MMA(1, 1, At, B1); PG8_BAR; PG8_SCHED;
            PG8_LDB(B0, 1, 0); PG8_LDB(B1, 1, 1); PG8_SCHED; PG8_LDA(At, 1, 0); PG8_STAGE(PG8_SA(0, 1), a2 + hstep, voffA);
            PG8_WAIT_V(8); PG8_WAIT_L(0); PG8_BAR; PG8_MMA(0, 0, At, B0); PG8_MMA(0, 1, At, B1); PG8_BAR; PG8_SCHED;
            PG8_LDA(At, 1, 1); PG8_STAGE(PG8_SB(1, 0), b3, voffB); PG8_STAGE(PG8_SB(1, 1), b3 + hstep, voffB); PG8_STAGE(PG8_SA(1, 0), a3, voffA);
            PG8_WAIT_V(8); PG8_WAIT_L(0); PG8_BAR; PG8_MMA(1, 0, At, B0); PG8_MMA(1, 1, At, B1); PG8_BAR; PG8_SCHED;
            } else {
            PG8_LDB(B0, 0, 0); PG8_SCHED; PG8_LDA(At, 0, 0); PG8_STAGE(PG8_SA(1, 1), a1 + hstep, voffA);
            PG8_WAIT_L(8); PG8_BAR; PG8_WAIT_L(0); PG8_MMA(0, 0, At, B0); PG8_BAR; PG8_SCHED;
            PG8_LDB(B1, 0, 1); PG8_STAGE(PG8_SB(0, 0), b2, voffB);
            PG8_BAR; PG8_WAIT_L(0); PG8_MMA(0, 1, At, B1); PG8_BAR;
            PG8_LDA(At, 0, 1); PG8_STAGE(PG8_SA(0, 0), a2, voffA);
            PG8_BAR; PG8_WAIT_L(0); PG8_MMA(1, 0, At, B0); PG8_BAR; PG8_SCHED;
            PG8_STAGE(PG8_SB(0, 1), b2 + hstep, voffB);
            PG8_WAIT_V(6); PG8_BAR; PG8_MMA(1, 1, At, B1); PG8_BAR;
            PG8_LDB(B0, 1, 0); PG8_SCHED; PG8_LDA(At, 1, 0); PG8_STAGE(PG8_SA(0, 1), a2 + hstep, voffA);
            PG8_WAIT_L(8); PG8_BAR; PG8_WAIT_L(0); PG8_MMA(0, 0, At, B0); PG8_BAR; PG8_SCHED;
            PG8_LDB(B1, 1, 1); PG8_STAGE(PG8_SB(1, 0), b3, voffB);
            PG8_BAR; PG8_WAIT_L(0); PG8_MMA(0, 1, At, B1); PG8_BAR;
            PG8_LDA(At, 1, 1); PG8_STAGE(PG8_SA(1, 0), a3, voffA);
            PG8_BAR; PG8_WAIT_L(0); PG8_MMA(1, 0, At, B0); PG8_BAR; PG8_SCHED;
            PG8_STAGE(PG8_SB(1, 1), b3 + hstep, voffB);
            PG8_WAIT_V(6); PG8_BAR; PG8_MMA(1, 1, At, B1); PG8_BAR;
            }
        }
        if constexpr (ALIGN_EPI) { if (wr == 0) PG8_BAR; }
        if constexpr (!Epi::AFTER_DRAIN) { E(acc, cur, wr, wc, fr, fq, auxb + (ui & 1) * 4096); S.done(cur); }
        if (!has_next) break;
#pragma unroll
        for (int a = 0; a < 2; ++a)
#pragma unroll
            for (int b = 0; b < 2; ++b)
#pragma unroll
                for (int m = 0; m < 4; ++m)
#pragma unroll
                    for (int n = 0; n < 2; ++n) acc[a][b][m][n] = (f32x4){0.f, 0.f, 0.f, 0.f};
        cur = nxt; cA = nA; cB = nB; ++ui;
        if constexpr (Epi::PREP) E.prep(auxb + (ui & 1) * 4096, cur, wid, lane);
        if constexpr (ALIGN_EPI) { if (wr == 1) PG8_BAR; }
    }
    PG8_WAIT_V(0);
    if constexpr (!ALIGN_EPI) { if (wr == 0) PG8_BAR; }
    PG8_BAR;
    if constexpr (Epi::AFTER_DRAIN) { E.fused(acc, cur, wr, wc, fr, fq, lds, wid, lane); S.done(cur); }
#undef PG8_SA
#undef PG8_SB
#undef PG8_STAGE
#undef PG8_LDA
#undef PG8_LDB
#undef PG8_MMA
#undef PG8_WAIT_V
#undef PG8_WAIT_L
#undef PG8_BAR
#undef PG8_SCHED
}
}
#define GAS __attribute__((address_space(1)))
#define LAS __attribute__((address_space(3)))
typedef unsigned short bf16;
typedef unsigned v4u __attribute__((ext_vector_type(4)));
typedef float f32x4 __attribute__((ext_vector_type(4)));
typedef short bf16x8 __attribute__((ext_vector_type(8)));
typedef GAS unsigned gu32;
typedef GAS unsigned long long gu64;
#define RLX_AGENT __ATOMIC_RELAXED, __HIP_MEMORY_SCOPE_AGENT
#define LDS_WAIT() asm volatile("s_waitcnt lgkmcnt(0)" ::: "memory")
#define VM_WAIT() asm volatile("s_waitcnt vmcnt(0)" ::: "memory")
__device__ __forceinline__ unsigned long long rt() { return __builtin_amdgcn_s_memrealtime(); }
__device__ __forceinline__ unsigned f2bf(float f) { unsigned u = __builtin_bit_cast(unsigned, f); return (u + 0x7fffu + ((u >> 16) & 1u)) >> 16; }
__device__ __forceinline__ unsigned pk2(float lo, float hi) { return f2bf(lo) | (f2bf(hi) << 16); }

#define XB_TMO      128
#define XB_XCNT(j)  (256  + 64 * (j))
#define XB_XSUB(j)  (1280 + 64 * (j))
#define XB_XGEN(j)  (2304 + 64 * (j))
#define XB_TOP      3328
#define XB_TOPGEN   3392
#define XCD_BAR_WORDS 3456
#define XB_SPIN_CAP (1u << 26)

__device__ __forceinline__ unsigned xb_ld(unsigned* p)              { return __hip_atomic_load(p, __ATOMIC_RELAXED, __HIP_MEMORY_SCOPE_AGENT); }
__device__ __forceinline__ unsigned xb_add(unsigned* p, unsigned v) { return __hip_atomic_fetch_add(p, v, __ATOMIC_RELAXED, __HIP_MEMORY_SCOPE_AGENT); }
__device__ __forceinline__ unsigned xb_xcc_id() { return (unsigned)__builtin_amdgcn_s_getreg((3 << 11) | 20) & 0xFu; }
#define XB_SPIN(cond, bar) do { unsigned _sp = 0; while (cond) { __builtin_amdgcn_s_sleep(1); \
    if ((++_sp & 255u) == 0u) { if (xb_ld(&(bar)[XB_TMO])) break; if (_sp > XB_SPIN_CAP) { atomicAdd(&(bar)[XB_TMO], 1u); break; } } } } while (0)

struct XcdBarrier {
    unsigned* bar; unsigned x;
    volatile LAS unsigned* st;
};

__device__ __forceinline__ XcdBarrier xcd_barrier_post(unsigned* bar, volatile LAS unsigned* st) {
    XcdBarrier b; b.bar = bar; b.x = xb_xcc_id(); b.st = st;
    if (threadIdx.x == 0) (void)xb_add(&bar[XB_XCNT(b.x)], 1u);
    return b;
}
__device__ __forceinline__ void xcd_barrier_complete(unsigned* bar, unsigned x, unsigned& nloc, unsigned& nx) {
    const unsigned G = gridDim.x * gridDim.y * gridDim.z;
    unsigned sum, cnt, mine, sp = 0u;
    for (;;) {
        sum = 0u; cnt = 0u; mine = 0u;
#pragma unroll
        for (unsigned j = 0; j < 16; ++j) { const unsigned c = xb_ld(&bar[XB_XCNT(j)]); sum += c; cnt += (c > 0u) ? 1u : 0u; mine = (j == x) ? c : mine; }
        if (sum == G) break;
        __builtin_amdgcn_s_sleep(1);
        if ((++sp & 255u) == 0u) { if (xb_ld(&bar[XB_TMO])) break; if (sp > XB_SPIN_CAP) { atomicAdd(&bar[XB_TMO], 1u); break; } }
    }
    nloc = mine > 0u ? mine : 1u; nx = cnt > 0u ? cnt : 1u;
}

__device__ __forceinline__ void xcd_barrier(const XcdBarrier& b) {
    asm volatile("s_waitcnt vmcnt(0)" ::: "memory");
    __syncthreads();
    if (threadIdx.x == 0) {
        unsigned* bar = b.bar;
        __builtin_amdgcn_s_waitcnt(0);
        unsigned nloc = b.st[0], nx = b.st[1];
        if (nloc == 0u) { xcd_barrier_complete(bar, b.x, nloc, nx); b.st[0] = nloc; b.st[1] = nx; }
        const unsigned old = xb_add(&bar[XB_XSUB(b.x)], 1u);
        const unsigned gen = old / nloc;
        if (old + 1u == (gen + 1u) * nloc) {
            __builtin_amdgcn_fence(__ATOMIC_RELEASE, "agent");
            asm volatile("s_waitcnt vmcnt(0)" ::: "memory");
            asm volatile("buffer_inv sc1" ::: "memory");
            const unsigned og = xb_add(&bar[XB_TOP], 1u);
            const unsigned tg = og / nx;
            if (og + 1u == (tg + 1u) * nx) xb_add(&bar[XB_TOPGEN], 1u);
            else XB_SPIN(xb_ld(&bar[XB_TOPGEN]) == tg, bar);
            asm volatile("s_waitcnt vmcnt(0)" ::: "memory");
        } else {
            asm volatile("buffer_inv sc1" ::: "memory");
            XB_SPIN(xb_ld(&bar[XB_TOPGEN]) == gen, bar);
            asm volatile("s_waitcnt vmcnt(0)" ::: "memory");
        }
    }
    __syncthreads();
}

constexpr int NWAVES = 8;
constexpr int D = 1024, NBATCH = 4, SEQ = 4096, MP = NBATCH * SEQ, MS = 32, MROWS = MP + MS, MPAD = 16640;
constexpr int DFF = 2816, INCOLS = 6400, KCAT = 1280;
static_assert(MP == pg8::P_MP && MROWS == pg8::P_MROWS && DFF == pg8::P_DFF, "constants");
constexpr size_t O_W0P = (size_t)MROWS * D, O_W1P = O_W0P + 262144, O_W2P = O_W1P + 1048576, O_PP = O_W2P + 4194304, O_MKV = O_PP + 30720,
                 O_W0S = O_MKV + 1048576, O_W1S = O_W0S + 16384, O_W2S = O_W1S + 16384, O_PS = O_W2S + 16384, O_END = O_PS + 16384;
constexpr size_t MiB = 1u << 20;
constexpr size_t WS_CTL = 0, CTL_ZERO_BYTES = MiB;
constexpr size_t WS_SSQ0 = 1 * MiB, WS_SSQ1 = WS_SSQ0 + 512 * 1024, WS_SSQ2 = 2 * MiB, WS_SSQ3 = WS_SSQ2 + 512 * 1024, WS_SSQM = 3 * MiB, WS_BIAS = WS_SSQM + 256 * 1024, WS_BIAS2 = WS_BIAS + 8192;
constexpr size_t WS_W1GU = 4 * MiB, WS_W1D = 15 * MiB, WS_WIN = WS_W1D + 5632 * 1024, WS_WMEM = 33 * MiB, WS_WOA = 35 * MiB, WS_WOB = WS_WOA + 512 * 1024, WS_WOC = WS_WOB + MiB,
                 WS_WOUT = WS_WOC + MiB, WS_W2GU = WS_WOUT + 2 * MiB, WS_W2D = WS_W2GU + 11 * MiB, WS_WPOOL = 56 * MiB;
constexpr size_t WS_AMEM = 57 * MiB, WS_MEMKV = 59 * MiB, WS_XB = 61 * MiB, WS_H = 94 * MiB, WS_QKV = WS_H, WS_QM = 298 * MiB + 512 * 1024;
constexpr size_t WS_G = 184 * MiB, WS_Z = 282 * MiB, WS_MB = 315 * MiB, WS_O3 = 315 * MiB, WS_LSE = 364 * MiB, WS_ABC = 365 * MiB, WS_END = 408 * MiB;
static_assert(WS_W1GU + 5632ull * 1024 * 2 <= WS_W1D && WS_W1D + 1024ull * 2816 * 2 <= WS_WIN && WS_WIN + 6400ull * 1024 * 2 <= WS_WMEM && WS_W2D + 1024ull * 2816 * 2 <= WS_WPOOL, "weight map");
static_assert(WS_XB + (size_t)MPAD * 1024 * 2 <= WS_H && WS_H + (size_t)MPAD * 2816 * 2 <= WS_G && WS_QKV + (size_t)MPAD * 2304 * 2 <= WS_H + (size_t)MP * 2816 * 2, "map 1");
static_assert(WS_G + (size_t)MPAD * 3072 * 2 <= WS_Z && WS_Z + (size_t)MPAD * 512 * 2 <= WS_QM && WS_QM + (size_t)MPAD * 512 * 2 <= WS_O3 && WS_MB + (size_t)MPAD * 1024 * 2 <= WS_LSE && WS_O3 + 3ull * MPAD * 256 * 4 <= WS_LSE, "map 2");
static_assert(WS_ABC + (size_t)MPAD * 1280 * 2 <= WS_END && WS_WOA + 1024ull * 1280 * 2 <= WS_WOUT, "map 3");
constexpr int CW_BAR = 4096, CW_FIN = 16384, CW_FINS = CW_FIN + 64 * 64, CW_SMP = 40960;
constexpr int RING_BYTES = 131072, LDSCTL_OFF = RING_BYTES, MISC_OFF = LDSCTL_OFF + 320, LDS_BYTES = 147456;

struct Args { const float* in[28]; float* out; unsigned char* ws; };

__device__ __forceinline__ float wave_sum(float v) {
#pragma unroll
    for (int o = 1; o < 64; o <<= 1) v += __shfl_xor(v, o);
    return v;
}
__device__ __forceinline__ float wave_max(float v) {
#pragma unroll
    for (int o = 1; o < 64; o <<= 1) v = fmaxf(v, __shfl_xor(v, o));
    return v;
}
__device__ __forceinline__ float bf2f(bf16 v) { return __uint_as_float((unsigned)v << 16); }
__device__ __forceinline__ float blo(unsigned w) { return __uint_as_float(w << 16); }
__device__ __forceinline__ float bhi(unsigned w) { return __uint_as_float(w & 0xffff0000u); }

__device__ __forceinline__ void p0_transpose_item(const float* W, int N, const float* gs, bf16* WT, int Kd, int k0, int n0, int drow0, LAS float* scr, int lane) {
    float wv[32];
#pragma unroll
    for (int i = 0; i < 32; ++i) wv[i] = __builtin_nontemporal_load(W + (size_t)(k0 + 2 * i + (lane >> 5)) * N + n0 + (lane & 31));
    if (gs) {
#pragma unroll
        for (int i = 0; i < 32; ++i) wv[i] *= gs[k0 + 2 * i + (lane >> 5)]; }
#pragma unroll
    for (int i = 0; i < 32; ++i) scr[(2 * i + (lane >> 5)) * 33 + (lane & 31)] = wv[i];
    LDS_WAIT(); asm volatile("" ::: "memory");
    const int c = lane & 7;
#pragma unroll
    for (int j = 0; j < 4; ++j) { const int n = (lane >> 3) + 8 * j; const LAS float* s = scr + (8 * c) * 33 + n;
        v4u o; o.x = pk2(s[0 * 33], s[1 * 33]); o.y = pk2(s[2 * 33], s[3 * 33]); o.z = pk2(s[4 * 33], s[5 * 33]); o.w = pk2(s[6 * 33], s[7 * 33]);
        *(GAS v4u*)(WT + (size_t)(drow0 + n) * Kd + k0 + 8 * c) = o; }
    LDS_WAIT(); asm volatile("" ::: "memory");
}
__device__ __forceinline__ void p0_matrix_item(const float* W, int K, int N, const float* gs, bf16* WT, int mode, int r, LAS float* scr, int lane) {
    const int nblk = N / 32, kb = r / nblk, nb = r % nblk, n0 = 32 * nb;
    const int drow0 = (mode == 0) ? n0 : ((n0 >> 7) * 256 + (n0 & 127) + (mode == 2 ? 128 : 0));
    p0_transpose_item(W, N, gs, WT, K, 64 * kb, n0, drow0, scr, lane);
}
__device__ __forceinline__ void p0_matrix_item_cat(const float* W, int K, int N, bf16* WT, int Kd, int kofs, int r, LAS float* scr, int lane) {
    const int nblk = N / 32, kb = r / nblk, nb = r % nblk;
    p0_transpose_item(W, N, nullptr, WT + kofs, Kd, 64 * kb, 32 * nb, 32 * nb, scr, lane);
}
__device__ __forceinline__ void p0_row2(const float* xa, bf16* oa, float* sa, const float* xb, bf16* ob, float* sb, int lane) {
    const GAS f32x4* ra = (const GAS f32x4*)xa + lane; const GAS f32x4* rb = (const GAS f32x4*)xb + lane;
    f32x4 va[4], vb[4]; float s0 = 0.f, s1 = 0.f;
#pragma unroll
    for (int j = 0; j < 4; ++j) { va[j] = __builtin_nontemporal_load(ra + 64 * j); vb[j] = __builtin_nontemporal_load(rb + 64 * j); }
#pragma unroll
    for (int j = 0; j < 4; ++j) { s0 += (va[j].x * va[j].x + va[j].y * va[j].y) + (va[j].z * va[j].z + va[j].w * va[j].w); s1 += (vb[j].x * vb[j].x + vb[j].y * vb[j].y) + (vb[j].z * vb[j].z + vb[j].w * vb[j].w); }
    s0 = wave_sum(s0); s1 = wave_sum(s1);
    GAS unsigned long long* pa = (GAS unsigned long long*)oa + lane; GAS unsigned long long* pb = (GAS unsigned long long*)ob + lane;
#pragma unroll
    for (int j = 0; j < 4; ++j) { pa[64 * j] = (unsigned long long)pk2(va[j].x, va[j].y) | ((unsigned long long)pk2(va[j].z, va[j].w) << 32);
        pb[64 * j] = (unsigned long long)pk2(vb[j].x, vb[j].y) | ((unsigned long long)pk2(vb[j].z, vb[j].w) << 32); }
    if (lane == 0) { *(f32x4*)sa = (f32x4){s0, 0.f, 0.f, 0.f}; *(f32x4*)sb = (f32x4){s1, 0.f, 0.f, 0.f}; }
}
__device__ __forceinline__ void p0_row(const float* xrow, bf16* orow, float* ssq, int lane) {
    const GAS f32x4* xr = (const GAS f32x4*)xrow + lane;
    f32x4 v[4]; float s = 0.f;
#pragma unroll
    for (int j = 0; j < 4; ++j) { v[j] = xr[64 * j]; s += (v[j].x * v[j].x + v[j].y * v[j].y) + (v[j].z * v[j].z + v[j].w * v[j].w); }
    s = wave_sum(s);
    GAS unsigned long long* o8 = (GAS unsigned long long*)orow + lane;
#pragma unroll
    for (int j = 0; j < 4; ++j) o8[64 * j] = (unsigned long long)pk2(v[j].x, v[j].y) | ((unsigned long long)pk2(v[j].z, v[j].w) << 32);
    if (lane == 0) *(f32x4*)ssq = (f32x4){s, 0.f, 0.f, 0.f};
}

typedef float f32x16 __attribute__((ext_vector_type(16)));
template <int K>
__device__ __forceinline__ void mini_gemm32(LAS unsigned char* lds, const bf16* A, const bf16* Bt, int col0, int wave, int lane, int lda = K, int ldb = K) {
    constexpr int KS = K / 8, NS = KS / 16, NB = (NS > 6) ? 6 : NS;
    const int k0 = wave * KS;
    const bf16* ap = A + (size_t)(lane & 31) * lda + k0 + 8 * (lane >> 5);
    const bf16* bp = Bt + (size_t)(col0 + (lane & 31)) * ldb + k0 + 8 * (lane >> 5);
    f32x16 acc = {0.f, 0.f, 0.f, 0.f, 0.f, 0.f, 0.f, 0.f, 0.f, 0.f, 0.f, 0.f, 0.f, 0.f, 0.f, 0.f};
#pragma unroll
    for (int s0 = 0; s0 < NS; s0 += NB) { bf16x8 av[NB], bv[NB];
#pragma unroll
        for (int j = 0; j < NB; ++j) if (s0 + j < NS) { av[j] = *(const bf16x8*)(ap + 16 * (s0 + j)); bv[j] = *(const bf16x8*)(bp + 16 * (s0 + j)); }
#pragma unroll
        for (int j = 0; j < NB; ++j) if (s0 + j < NS) acc = __builtin_amdgcn_mfma_f32_32x32x16_bf16(av[j], bv[j], acc, 0, 0, 0); }
    LAS float* part = (LAS float*)lds;
#pragma unroll
    for (int r = 0; r < 16; ++r) part[(wave * 16 + r) * 64 + lane] = acc[r];
    __syncthreads();
}
__device__ __forceinline__ float mini_elem(LAS unsigned char* lds, int tid, int i, int& row, int& col) {
    const int r = (tid >> 6) + 8 * i, l = tid & 63; const LAS float* part = (const LAS float*)lds; float v = 0.f;
#pragma unroll
    for (int w = 0; w < 8; ++w) v += part[(w * 16 + r) * 64 + l];
    row = (r & 3) + 8 * (r >> 2) + 4 * (l >> 5); col = l & 31; return v;
}
__device__ __forceinline__ float half_sum32(float s) { s += __shfl_xor(s, 1); s += __shfl_xor(s, 2); s += __shfl_xor(s, 4); s += __shfl_xor(s, 8); s += __shfl_xor(s, 16); return s; }
template <int K>
__device__ __forceinline__ void sample_resid(LAS unsigned char* lds, const bf16* A, const bf16* Bt, const float* basef, bf16* xb, float* ssq_out, float scale, int ct, int tid, int wave, int lane) {
    mini_gemm32<K>(lds, A, Bt, 32 * ct, wave, lane);
#pragma unroll
    for (int i = 0; i < 2; ++i) { int row, col; const float v = mini_elem(lds, tid, i, row, col); const size_t off = (size_t)row * 1024 + 32 * ct + col;
        const float xn = (basef ? basef[off] : bf2f(xb[off])) + scale * v; xb[off] = (bf16)f2bf(xn);
        const float s = half_sum32(xn * xn); if ((lane & 31) == 0) atomicAdd(ssq_out + row * 4 + (ct & 3), s); }
    __syncthreads();
}
template <int K>
__device__ __forceinline__ void sample_final(LAS unsigned char* lds, const bf16* A, const bf16* Bt, const bf16* base, float* out, const float* gfin, float* ssq, unsigned* cnt, float scale, int ct, int tid, int wave, int lane) {
    mini_gemm32<K>(lds, A, Bt, 32 * ct, wave, lane);
    float xn[2]; int rr[2], cc[2];
#pragma unroll
    for (int i = 0; i < 2; ++i) { const float v = mini_elem(lds, tid, i, rr[i], cc[i]); xn[i] = bf2f(base[(size_t)rr[i] * 1024 + 32 * ct + cc[i]]) + scale * v;
        const float s = half_sum32(xn[i] * xn[i]); if ((lane & 31) == 0) atomicAdd(ssq + rr[i] * 4 + (ct & 3), s); }
    asm volatile("s_waitcnt vmcnt(0)" ::: "memory");
    __syncthreads();
    if (tid == 0) { __hip_atomic_fetch_add(cnt, 1u, __ATOMIC_RELAXED, __HIP_MEMORY_SCOPE_AGENT);
        unsigned sp = 0; while (__hip_atomic_load(cnt, __ATOMIC_RELAXED, __HIP_MEMORY_SCOPE_AGENT) < 32u) { __builtin_amdgcn_s_sleep(1); if (++sp > (1u << 24)) break; } }
    __syncthreads();
#pragma unroll
    for (int i = 0; i < 2; ++i) { const float* sp4 = ssq + rr[i] * 4;
        const float a = __hip_atomic_load(sp4, __ATOMIC_RELAXED, __HIP_MEMORY_SCOPE_AGENT), b = __hip_atomic_load(sp4 + 1, __ATOMIC_RELAXED, __HIP_MEMORY_SCOPE_AGENT),
                    c = __hip_atomic_load(sp4 + 2, __ATOMIC_RELAXED, __HIP_MEMORY_SCOPE_AGENT), d = __hip_atomic_load(sp4 + 3, __ATOMIC_RELAXED, __HIP_MEMORY_SCOPE_AGENT);
        const float ri = rsqrtf(((a + b) + (c + d)) * (1.0f / 1024.0f) + 1e-6f);
        out[(size_t)rr[i] * 1024 + 32 * ct + cc[i]] = xn[i] * ri * gfin[32 * ct + cc[i]]; }
    __syncthreads();
}

__device__ __forceinline__ void wg_publish(unsigned* cnt, int tid) {
    asm volatile("s_waitcnt vmcnt(0)" ::: "memory"); __syncthreads();
    if (tid == 0) { __builtin_amdgcn_fence(__ATOMIC_RELEASE, "agent"); asm volatile("s_waitcnt vmcnt(0)" ::: "memory"); __hip_atomic_fetch_add(cnt, 1u, __ATOMIC_RELAXED, __HIP_MEMORY_SCOPE_AGENT); }
}
__device__ __forceinline__ void wg_wait(unsigned* cnt, unsigned need, int tid) {
    if (tid == 0) { unsigned sp = 0; while (__hip_atomic_load(cnt, __ATOMIC_RELAXED, __HIP_MEMORY_SCOPE_AGENT) < need) { __builtin_amdgcn_s_sleep(2); if (++sp > (1u << 24)) break; }
        __builtin_amdgcn_fence(__ATOMIC_ACQUIRE, "agent"); asm volatile("s_waitcnt vmcnt(0)" ::: "memory"); }
    __syncthreads();
}

typedef short s16x4 __attribute__((ext_vector_type(4)));
#define KO(r) (((r) & 3) + 8 * ((r) >> 2))
constexpr float LOG2E = 1.4426950408889634f;
constexpr float MASKV = -1e30f, MINIT = -5e29f;
constexpr int TAB_N = 384;
__device__ __forceinline__ s16x4 vtr(const LAS unsigned char* p) { return __builtin_bit_cast(s16x4, __builtin_amdgcn_ds_read_tr16_b64_v4i16((LAS s16x4*)p)); }

template <int DH>
__device__ __forceinline__ void attn_finish(f32x16 (&o)[DH / 32], float l, bf16* dst, size_t qstride, LAS float* xch, int lane) {
    constexpr int DB = DH / 32; const int h = lane >> 5;
    l += __shfl_xor(l, 32);
    if (h == 0) xch[lane] = 1.0f / l;
    LDS_WAIT(); asm volatile("" ::: "memory");
#pragma unroll
    for (int r = 0; r < 16; ++r) { const float il = xch[KO(r) + 4 * h]; bf16* dq = dst + qstride * (size_t)(KO(r) + 4 * h) + (lane & 31);
#pragma unroll
        for (int db = 0; db < DB; ++db) dq[32 * db] = (bf16)f2bf(o[db][r] * il); }
    asm volatile("" ::: "memory");
}
template <int DH, bool TAB>
__device__ __forceinline__ void softmax_pv(const f32x16 s, f32x16 (&o)[DH / 32], float& m, float& l, const LAS unsigned char* vt, const LAS float* tb, int kmin, LAS float* xch, int lane) {
    constexpr int DB = DH / 32, VP = DH * 2 + 64; const int h = lane >> 5;
    float x[16];
#pragma unroll
    for (int r = 0; r < 16; ++r) x[r] = TAB ? __builtin_fmaf(s[r], LOG2E, tb[KO(r)]) : s[r] * LOG2E;
    if (kmin > 0) {
#pragma unroll
        for (int r = 0; r < 16; ++r) if (KO(r) + 4 * h < kmin) x[r] = MASKV;
    }
    float bm = fmaxf(fmaxf(x[0], x[1]), fmaxf(x[2], x[3]));
#pragma unroll
    for (int r = 4; r < 16; r += 4) bm = fmaxf(bm, fmaxf(fmaxf(x[r], x[r + 1]), fmaxf(x[r + 2], x[r + 3])));
    bm = fmaxf(bm, __shfl_xor(bm, 32));
    const float mn = fmaxf(m, bm);
    if (__any(bm > m + 8.0f)) {
        const float a = __builtin_amdgcn_exp2f(m - mn); l *= a; m = mn;
        if (h == 0) xch[lane] = a;
        LDS_WAIT(); asm volatile("" ::: "memory");
#pragma unroll
        for (int r = 0; r < 16; ++r) { const float ar = xch[KO(r) + 4 * h];
#pragma unroll
            for (int db = 0; db < DB; ++db) o[db][r] *= ar; }
        asm volatile("" ::: "memory");
    }
    float ps = 0.f;
#pragma unroll
    for (int r = 0; r < 16; ++r) { x[r] = __builtin_amdgcn_exp2f(x[r] - m); ps += x[r]; }
    l += ps;
    v4u pw0, pw1;
    pw0.x = pg8::cvt_pk_bf16(x[0], x[1]); pw0.y = pg8::cvt_pk_bf16(x[2], x[3]); pw0.z = pg8::cvt_pk_bf16(x[4], x[5]); pw0.w = pg8::cvt_pk_bf16(x[6], x[7]);
    pw1.x = pg8::cvt_pk_bf16(x[8], x[9]); pw1.y = pg8::cvt_pk_bf16(x[10], x[11]); pw1.z = pg8::cvt_pk_bf16(x[12], x[13]); pw1.w = pg8::cvt_pk_bf16(x[14], x[15]);
    const bf16x8 pa0 = __builtin_bit_cast(bf16x8, pw0), pa1 = __builtin_bit_cast(bf16x8, pw1);
    const LAS unsigned char* vb = vt + (((lane & 15) >> 2) + 4 * h) * VP + (16 * ((lane >> 4) & 1) + 4 * (lane & 3)) * 2;
#pragma unroll
    for (int db = 0; db < DB; ++db) {
        const s16x4 l0 = vtr(vb + db * 64), h0 = vtr(vb + db * 64 + 8 * VP), l1 = vtr(vb + db * 64 + 16 * VP), h1 = vtr(vb + db * 64 + 24 * VP);
        const bf16x8 b0 = {l0[0], l0[1], l0[2], l0[3], h0[0], h0[1], h0[2], h0[3]}, b1 = {l1[0], l1[1], l1[2], l1[3], h1[0], h1[1], h1[2], h1[3]};
        o[db] = __builtin_amdgcn_mfma_f32_32x32x16_bf16(pa0, b0, o[db], 0, 0, 0);
        o[db] = __builtin_amdgcn_mfma_f32_32x32x16_bf16(pa1, b1, o[db], 0, 0, 0);
    }
}
struct KVBuf { v4u kr[4]; v4u vr[4]; };
__device__ __forceinline__ void attn_load64(KVBuf& B, const bf16* vp, long vstep, int imin) {
#pragma unroll
    for (int i = 0; i < 4; ++i) { const bf16* p = vp + (long)(i < imin ? imin : i) * vstep; B.kr[i] = *(const v4u*)(p - 768); B.vr[i] = *(const v4u*)p; }
}
__device__ __forceinline__ void attn_compute64(const KVBuf& B, const bf16x8 (&qf)[4], f32x16 (&o)[2], float& m, float& l, LAS unsigned char* kl  , const LAS float* tb, int kmin, LAS float* xch, int lane) {
    const int q = lane & 31, h = lane >> 5; LAS unsigned char* vl = kl + 4608;
#pragma unroll
    for (int i = 0; i < 4; ++i) { *(LAS v4u*)(kl + ((lane >> 3) + 8 * i) * 144 + (lane & 7) * 16) = B.kr[i]; *(LAS v4u*)(vl + ((lane >> 3) + 8 * i) * 192 + (lane & 7) * 16) = B.vr[i]; }
    f32x16 s = {0.f, 0.f, 0.f, 0.f, 0.f, 0.f, 0.f, 0.f, 0.f, 0.f, 0.f, 0.f, 0.f, 0.f, 0.f, 0.f};
#pragma unroll
    for (int ks = 0; ks < 4; ++ks) { const bf16x8 kf = *(const LAS bf16x8*)(kl + q * 144 + (16 * ks + 8 * h) * 2); s = __builtin_amdgcn_mfma_f32_32x32x16_bf16(kf, qf[ks], s, 0, 0, 0); }
    softmax_pv<64, true>(s, o, m, l, vl, tb, kmin, xch, lane);
}
__device__ __forceinline__ void attn_job(const bf16* QKV, bf16* AO, int b, int hh, int n, int c, LAS unsigned char* vl, const LAS float* tabL, LAS float* xch, int lane) {
    const long rowb = (long)b * 4096; const int T0 = 128 * n;
    const int kb0 = (n == 0) ? 4 : 0, c0 = 8 - kb0, kb1 = (n < 4) ? 4 - n : 0, c1 = 5 - kb1;
    int kb2 = 0; while (8 * n - 128 + 32 * kb2 + 31 < 0) ++kb2;
    f32x16 o[2]; float m = MINIT, l = 0.f;
#pragma unroll
    for (int r = 0; r < 16; ++r) { o[0][r] = 0.f; o[1][r] = 0.f; }
    bf16x8 qf[4];
    for (int st = 0; st < 6; ++st) {
        const int g = (st < 2) ? st : 2, rc = st - 2;
        const int kbf = (g == 0) ? kb0 : (g == 1) ? kb1 : kb2, cnt = (g == 0) ? c0 : (g == 1) ? c1 : 5 - kb2;
        int ln = lane; asm volatile("" : "+v"(ln)); const int q = ln & 31, h = ln >> 5;
        if (st <= 2) { const bf16* qr = QKV + (rowb + T0 + c + 4 * q) * 2304 + hh * 64 + 8 * h + 256 * g;
#pragma unroll
            for (int ks = 0; ks < 4; ++ks) qf[ks] = *(const bf16x8*)(qr + 16 * ks); }
        asm volatile("" ::: "memory");
        long row; long vstep; const LAS float* tb; int kmin = 0;
        if (g == 0) { row = rowb + T0 - 128 + 32 * kbf + (ln >> 3); vstep = 8 * 2304; tb = tabL + 127 + 32 * kbf + 4 * h - (c + 4 * q); }
        else if (g == 1) { row = rowb + 4 * ((long)32 * n - 128 + 32 * kbf + (ln >> 3)) + c; vstep = 32 * 2304; tb = tabL + TAB_N + 127 + 32 * kbf + 4 * h - q; }
        else { const int j0 = 8 * n - 128 + 32 * kbf; kmin = (j0 < 0) ? -j0 : 0; row = rowb + 16 * ((long)j0 + (ln >> 3)) + c + 4 * rc; vstep = 128 * 2304;
               tb = ((q & 3) == rc) ? tabL + 2 * TAB_N + 127 + 32 * kbf + 4 * h - (q >> 2) : tabL + 3 * TAB_N; }
        const bf16* vp = QKV + row * 2304 + 1536 + 256 * g + hh * 64 + (ln & 7) * 8;
        const long bstep = 4 * vstep;
        const int tstep = (g == 2 && (q & 3) != rc) ? 0 : 32;
        KVBuf A, Bb;
        attn_load64(A, vp, vstep, kmin >> 3);
        for (int i = 0; i < cnt; i += 2) {
            const bool has1 = (i + 1 < cnt), has2 = (i + 2 < cnt);
            const bf16* vp1 = has1 ? vp + bstep : vp; const bf16* vp2 = has2 ? vp + 2 * bstep : vp1;
            attn_load64(Bb, vp1, vstep, has1 ? 0 : (kmin >> 3));
            attn_compute64(A, qf, o, m, l, vl, tb, (i == 0) ? kmin : 0, xch, lane);
            attn_load64(A, vp2, vstep, (has2 || has1) ? 0 : (kmin >> 3));
            if (has1) attn_compute64(Bb, qf, o, m, l, vl, tb + tstep, 0, xch, lane);
            vp = vp2; tb += 2 * tstep;
        }
    }
    attn_finish<64>(o, l, AO + (rowb + T0 + c) * KCAT + hh * 64, (size_t)4 * KCAT, xch, lane);
}
__device__ __forceinline__ void memattn_wg(const bf16* QM, const bf16* KV, bf16* CO, int b, int hh, int qb, LAS unsigned char* Lb, LAS float* xch, int tid_, int lane_) {
    int tid = tid_; asm volatile("" : "+v"(tid)); const int lane = tid & 63;
    (void)lane_; const int q = lane & 31, h = lane >> 5;
    const size_t row0 = (size_t)b * 4096 + 32 * qb;
    const bf16* qrow = QM + (row0 + q) * 512 + hh * 128 + 8 * h;
    LAS unsigned char* Kt = Lb; LAS unsigned char* Vt = Lb + 128 * 272;
    f32x16 o[4]; float m = MINIT, l = 0.f;
#pragma unroll
    for (int r = 0; r < 16; ++r) { o[0][r] = 0.f; o[1][r] = 0.f; o[2][r] = 0.f; o[3][r] = 0.f; }
    bf16x8 qf[8];
#pragma unroll
    for (int ks = 0; ks < 8; ++ks) qf[ks] = *(const bf16x8*)(qrow + 16 * ks);
    for (int half = 0; half < 2; ++half) {
        __syncthreads();
        v4u kr[4], vr[4];
#pragma unroll
        for (int i = 0; i < 4; ++i) { const int idx = tid + 512 * i, row = idx >> 4, pc = idx & 15; const bf16* p = KV + ((size_t)b * 256 + 128 * half + row) * 1024 + hh * 128 + pc * 8; kr[i] = *(const v4u*)p; vr[i] = *(const v4u*)(p + 512); }
#pragma unroll
        for (int i = 0; i < 4; ++i) { const int idx = tid + 512 * i, row = idx >> 4, pc = idx & 15; *(LAS v4u*)(Kt + row * 272 + pc * 16) = kr[i]; *(LAS v4u*)(Vt + row * 320 + pc * 16) = vr[i]; }
        __syncthreads();
        for (int kb = 0; kb < 4; ++kb) {
            f32x16 s = {0.f, 0.f, 0.f, 0.f, 0.f, 0.f, 0.f, 0.f, 0.f, 0.f, 0.f, 0.f, 0.f, 0.f, 0.f, 0.f};
#pragma unroll
            for (int ks = 0; ks < 8; ++ks) { const bf16x8 kf = *(const LAS bf16x8*)(Kt + (32 * kb + q) * 272 + (16 * ks + 8 * h) * 2); s = __builtin_amdgcn_mfma_f32_32x32x16_bf16(kf, qf[ks], s, 0, 0, 0); }
            softmax_pv<128, false>(s, o, m, l, Vt + (32 * kb) * 320, nullptr, 0, xch, lane);
        }
    }
    attn_finish<128>(o, l, CO + row0 * KCAT + hh * 128, (size_t)KCAT, xch, lane);
}
__device__ __forceinline__ void pool_mma(const LAS unsigned char* tl, const bf16* WP, const float* pscale, bf16* BO, int m0, int gi, int lane) {
    constexpr int PITCH = 272; const int q = lane & 31, h = lane >> 5;
    f32x16 acc[4];
#pragma unroll
    for (int r = 0; r < 16; ++r) { acc[0][r] = 0.f; acc[1][r] = 0.f; acc[2][r] = 0.f; acc[3][r] = 0.f; }
    const bf16* wb = WP + (size_t)(gi * 128 + q) * 128 + 8 * h;
    bf16x8 bn[4];
#pragma unroll
    for (int db = 0; db < 4; ++db) bn[db] = *(const bf16x8*)(wb + db * 4096);
#pragma unroll
    for (int ks = 0; ks < 8; ++ks) { bf16x8 bc[4];
#pragma unroll
        for (int db = 0; db < 4; ++db) bc[db] = bn[db];
        if (ks < 7) {
#pragma unroll
            for (int db = 0; db < 4; ++db) bn[db] = *(const bf16x8*)(wb + db * 4096 + 16 * (ks + 1)); }
        const bf16x8 a = *(const LAS bf16x8*)(tl + q * PITCH + (16 * ks + 8 * h) * 2);
#pragma unroll
        for (int db = 0; db < 4; ++db) acc[db] = __builtin_amdgcn_mfma_f32_32x32x16_bf16(a, bc[db], acc[db], 0, 0, 0); }
#pragma unroll
    for (int db = 0; db < 4; ++db) { const float sc = pscale[gi * 128 + 32 * db + q];
#pragma unroll
        for (int r = 0; r < 16; ++r) BO[(size_t)(m0 + KO(r) + 4 * h) * KCAT + gi * 128 + 32 * db + q] = (bf16)f2bf(acc[db][r] * sc); }
    LDS_WAIT(); asm volatile("" ::: "memory");
}
template <int GI>
__device__ __forceinline__ void pool_job_t(const bf16* Z, const bf16* WP, const float* pscale, bf16* BO, int m0, LAS unsigned char* tl, int lane) {
    constexpr int PITCH = 272, KW = 2 << GI, NR = 31 + KW;
    const int t0s = m0 & 4095;
    unsigned zr[NR];
#pragma unroll
    for (int i = 0; i < NR; ++i) { const int tt = i - (KW - 1); zr[i] = (t0s + tt >= 0) ? *(const unsigned*)(Z + (size_t)(m0 + tt) * 512 + GI * 128 + 2 * lane) : 0u; }
    float S0 = 0.f, S1 = 0.f;
#pragma unroll
    for (int i = 0; i < KW - 1; ++i) { S0 += blo(zr[i]); S1 += bhi(zr[i]); }
#pragma unroll
    for (int tt = 0; tt < 32; ++tt) { const unsigned w = zr[tt + KW - 1]; const float z0 = blo(w), z1 = bhi(w);
        S0 += z0; S1 += z1;
        if (tt >= 1) { S0 -= blo(zr[tt - 1]); S1 -= bhi(zr[tt - 1]); }
        const int ts = t0s + tt, cnt = (ts + 1 < KW) ? ts + 1 : KW; const float inv = 1.0f / (float)cnt;
        *(LAS unsigned*)(tl + tt * PITCH + lane * 4) = pk2(S0 * inv - z0, S1 * inv - z1); }
    LDS_WAIT(); asm volatile("" ::: "memory");
    pool_mma(tl, WP, pscale, BO, m0, GI, lane);
}
__device__ __forceinline__ void pool_job(const bf16* Z, const bf16* WP, const float* pscale, bf16* BO, int m0, int gi, LAS unsigned char* tl, int lane_) {
    int lane = lane_; asm volatile("" : "+v"(lane));
    if (gi == 0) pool_job_t<0>(Z, WP, pscale, BO, m0, tl, lane); else if (gi == 1) pool_job_t<1>(Z, WP, pscale, BO, m0, tl, lane);
    else if (gi == 2) pool_job_t<2>(Z, WP, pscale, BO, m0, tl, lane); else pool_job_t<3>(Z, WP, pscale, BO, m0, tl, lane);
}
typedef unsigned v2u __attribute__((ext_vector_type(2)));
__device__ __forceinline__ f32x4 ld_bf4(const bf16* p) { const v2u w = *(const v2u*)p; return (f32x4){blo(w.x), bhi(w.x), blo(w.y), bhi(w.y)}; }
__device__ __forceinline__ float dot4(const f32x4 a, const f32x4 b) { return (a[0] * b[0] + a[1] * b[1]) + (a[2] * b[2] + a[3] * b[3]); }
__device__ __forceinline__ void sample_attn_group(const bf16* QKVrow  , const float* cache, const float* biasT, int s, int h, int g, LAS float* sx, int lane) {
    const int kq = lane >> 4, pc = lane & 15, W = 128 << (2 * g), dil = 1 << (2 * g);
    const f32x4 q4 = ld_bf4(QKVrow + g * 256 + h * 64 + 4 * pc);
    const f32x4 kn = ld_bf4(QKVrow + 768 + g * 256 + h * 64 + 4 * pc), vn = ld_bf4(QKVrow + 1536 + g * 256 + h * 64 + 4 * pc);
    float s0 = dot4(q4, kn); s0 += __shfl_xor(s0, 1); s0 += __shfl_xor(s0, 2); s0 += __shfl_xor(s0, 4); s0 += __shfl_xor(s0, 8);
    s0 += biasT[(g * 129) * 4 + h];
    const float* cb = cache + ((size_t)s * W) * 512 + h * 64 + 4 * pc;
    float sc[32];
#pragma unroll
    for (int it = 0; it < 32; ++it) { const int j = 1 + 4 * it + kq; const f32x4 kv = __builtin_nontemporal_load((const f32x4*)(cb + (size_t)(W - dil * j) * 512));
        float d = dot4(q4, kv); d += __shfl_xor(d, 1); d += __shfl_xor(d, 2); d += __shfl_xor(d, 4); d += __shfl_xor(d, 8);
        sc[it] = d + biasT[(g * 129 + j) * 4 + h]; }
    float m = s0;
#pragma unroll
    for (int it = 0; it < 32; ++it) m = fmaxf(m, sc[it]);
    m = fmaxf(m, __shfl_xor(m, 16)); m = fmaxf(m, __shfl_xor(m, 32));
    const float p0 = __expf(s0 - m); float l = 0.f; f32x4 acc = {0.f, 0.f, 0.f, 0.f};
#pragma unroll
    for (int it = 0; it < 32; ++it) { const int j = 1 + 4 * it + kq; const float p = __expf(sc[it] - m); l += p;
        const f32x4 vv = __builtin_nontemporal_load((const f32x4*)(cb + (size_t)(W - dil * j) * 512 + 256)); acc = acc + vv * p; }
    l += __shfl_xor(l, 16); l += __shfl_xor(l, 32); l += p0;
#pragma unroll
    for (int e = 0; e < 4; ++e) { float a = acc[e]; a += __shfl_xor(a, 16); a += __shfl_xor(a, 32); acc[e] = a + p0 * vn[e]; }
    const float il = 1.0f / l;
    if (kq == 0) *(LAS f32x4*)(sx + g * 72 + 4 * pc) = acc * il;
    if (lane == 0) sx[g * 72 + 64] = m + __logf(l);
}
__device__ __forceinline__ void sample_mem_quarter(const bf16* QMrow  , const float* cache, int s, int h, int qd, LAS float* sx, int lane) {
    const int kq = lane >> 5, pc = lane & 31;
    const f32x4 q4 = ld_bf4(QMrow + h * 128 + 4 * pc);
    const float* cb = cache + ((size_t)(s * 256 + 64 * qd) * 2) * 512 + h * 128 + 4 * pc;
    float sc[32];
#pragma unroll
    for (int it = 0; it < 32; ++it) { const f32x4 kv = __builtin_nontemporal_load((const f32x4*)(cb + (size_t)(2 * it + kq) * 1024));
        float d = dot4(q4, kv); d += __shfl_xor(d, 1); d += __shfl_xor(d, 2); d += __shfl_xor(d, 4); d += __shfl_xor(d, 8); d += __shfl_xor(d, 16); sc[it] = d; }
    float m = sc[0];
#pragma unroll
    for (int it = 1; it < 32; ++it) m = fmaxf(m, sc[it]);
    m = fmaxf(m, __shfl_xor(m, 32));
    float l = 0.f; f32x4 acc = {0.f, 0.f, 0.f, 0.f};
#pragma unroll
    for (int it = 0; it < 32; ++it) { const float p = __expf(sc[it] - m); l += p; const f32x4 vv = __builtin_nontemporal_load((const f32x4*)(cb + (size_t)(2 * it + kq) * 1024 + 512)); acc = acc + vv * p; }
    l += __shfl_xor(l, 32);
#pragma unroll
    for (int e = 0; e < 4; ++e) acc[e] += __shfl_xor(acc[e], 32);
    LAS float* o = sx + 256 + qd * 136;
    if (kq == 0) *(LAS f32x4*)(o + 4 * pc) = acc;
    if (lane == 0) { o[128] = m; o[129] = l; }
}
__device__ __forceinline__ void sample_combine(bf16* AOrow, bf16* COrow, int h, const LAS float* sx, int wave, int lane) {
    if (wave == 0) {
        const float l0 = sx[64], l1 = sx[72 + 64], l2 = sx[144 + 64], mm = fmaxf(fmaxf(l0, l1), l2);
        const float w0 = __expf(l0 - mm), w1 = __expf(l1 - mm), w2 = __expf(l2 - mm);
        AOrow[h * 64 + lane] = (bf16)f2bf((w0 * sx[lane] + w1 * sx[72 + lane] + w2 * sx[144 + lane]) / (w0 + w1 + w2));
    } else if (wave == 1) {
        float mm = sx[256 + 128];
#pragma unroll
        for (int qd = 1; qd < 4; ++qd) mm = fmaxf(mm, sx[256 + qd * 136 + 128]);
        float L = 0.f, a0 = 0.f, a1 = 0.f;
#pragma unroll
        for (int qd = 0; qd < 4; ++qd) { const LAS float* o = sx + 256 + qd * 136; const float w = __expf(o[128] - mm); L += w * o[129]; a0 += w * o[2 * lane]; a1 += w * o[2 * lane + 1]; }
        const float il = 1.0f / L;
        *(unsigned*)(COrow + h * 128 + 2 * lane) = pk2(a0 * il, a1 * il);
    }
}
__device__ __forceinline__ void sample_pool_fill(const bf16* Z  , const float* state, int gi, LAS unsigned char* tl, int wave, int lane) {
    const int kw = 2 << gi; const float inv = 1.0f / (float)kw;
#pragma unroll
    for (int k = 0; k < 4; ++k) { const int s = 4 * wave + k;
        const float z0 = bf2f(Z[(size_t)s * 512 + gi * 128 + lane]), z1 = bf2f(Z[(size_t)s * 512 + gi * 128 + 64 + lane]); float S0 = z0, S1 = z1;
        for (int i = 1; i < kw; ++i) { const float* sr = state + (size_t)(s * 15 + 15 - i) * 512 + gi * 128; S0 += sr[lane]; S1 += sr[64 + lane]; }
        *(LAS bf16*)(tl + s * 272 + lane * 2) = (bf16)f2bf(S0 * inv - z0); *(LAS bf16*)(tl + s * 272 + (64 + lane) * 2) = (bf16)f2bf(S1 * inv - z1); }
}

__global__ void __launch_bounds__(NWAVES * 64, 2) fwd_kernel(Args args) {
    extern __shared__ __attribute__((aligned(16))) unsigned char lds[];
    LAS unsigned char* const L = (LAS unsigned char*)lds;
    volatile LAS unsigned* MISC = (volatile LAS unsigned*)(L + MISC_OFF);
    const int tid = threadIdx.x, lane = tid & 63, wave = __builtin_amdgcn_readfirstlane(tid >> 6);
    const int G = gridDim.x, bx = blockIdx.x;
    const int vcu = (G % 8 == 0) ? (bx % 8) * (G / 8) + bx / 8 : bx;
    unsigned char* const ws = args.ws;
    gu32* ctl = (gu32*)(ws + WS_CTL);
    for (int u = tid; u < (LDS_BYTES - LDSCTL_OFF) / 4; u += NWAVES * 64) ((LAS unsigned*)(L + LDSCTL_OFF))[u] = 0u;
    __syncthreads();
    XcdBarrier bar = xcd_barrier_post((unsigned*)(ctl + CW_BAR), MISC + 8);
#define GRID_BAR() xcd_barrier(bar)
#define PHASE_IDS int tid = threadIdx.x; asm volatile("" : "+v"(tid)); const int lane = tid & 63, wave = __builtin_amdgcn_readfirstlane(tid >> 6); const int gw = vcu * NWAVES + wave; (void)lane; (void)gw
    const int NGW = G * NWAVES;
    float* const out = args.out;
    float* ssq0 = (float*)(ws + WS_SSQ0); float* ssq1 = (float*)(ws + WS_SSQ1); float* ssq2 = (float*)(ws + WS_SSQ2); float* ssq3 = (float*)(ws + WS_SSQ3); float* ssqm = (float*)(ws + WS_SSQM);
    bf16* XB = (bf16*)(ws + WS_XB); bf16* HB = (bf16*)(ws + WS_H); unsigned char* GB = (unsigned char*)(ws + WS_G); bf16* MB = (bf16*)(ws + WS_MB);

    constexpr int I_GU = 16 * 88, I_D = 44 * 32, I_IN = 16 * 200, I_MEM = 16 * 32, I_OA = 4 * 32, I_OB = 8 * 32, I_OUT = 16 * 32, I_PL = 2 * 4;
    constexpr int I_SET0 = 2 * I_GU + I_MEM, I_SET1 = I_D + I_IN + I_OA + 2 * I_OB + I_OUT + 4 * I_PL, I_SET2 = 3 * I_GU;
    static_assert(I_GU == I_D, "items");
#define CONVERT_ITEM(it_) do { int r = (it_); LAS float* scr = (LAS float*)(L + wave * 16384); \
        if (r < I_GU) { p0_matrix_item(args.in[10], 1024, 2816, args.in[9], (bf16*)(ws + WS_W1GU), 1, r, scr, lane); break; } r -= I_GU; \
        if (r < I_GU) { p0_matrix_item(args.in[11], 1024, 2816, args.in[9], (bf16*)(ws + WS_W1GU), 2, r, scr, lane); break; } r -= I_GU; \
        if (r < I_MEM) { p0_matrix_item(args.in[18], 1024, 1024, args.in[17], (bf16*)(ws + WS_WMEM), 0, r, scr, lane); break; } r -= I_MEM; \
        if (r < I_D) { p0_matrix_item(args.in[12], 2816, 1024, nullptr, (bf16*)(ws + WS_W1D), 0, r, scr, lane); break; } r -= I_D; \
        if (r < I_IN) { p0_matrix_item(args.in[14], 1024, 6400, args.in[13], (bf16*)(ws + WS_WIN), 0, r, scr, lane); break; } r -= I_IN; \
        if (r < I_OA) { p0_matrix_item_cat(args.in[19], 256, 1024, (bf16*)(ws + WS_WOA), KCAT, 0, r, scr, lane); break; } r -= I_OA; \
        if (r < I_OB) { p0_matrix_item_cat(args.in[20], 512, 1024, (bf16*)(ws + WS_WOA), KCAT, 256, r, scr, lane); break; } r -= I_OB; \
        if (r < I_OB) { p0_matrix_item_cat(args.in[21], 512, 1024, (bf16*)(ws + WS_WOA), KCAT, 768, r, scr, lane); break; } r -= I_OB; \
        if (r < I_OUT) { p0_matrix_item(args.in[22], 1024, 1024, nullptr, (bf16*)(ws + WS_WOUT), 0, r, scr, lane); break; } r -= I_OUT; \
        if (r < 4 * I_PL) { const int g_ = r / I_PL; p0_matrix_item(args.in[15] + (size_t)g_ * 16384, 128, 128, nullptr, (bf16*)(ws + WS_WPOOL) + (size_t)g_ * 16384, 0, r % I_PL, scr, lane); break; } r -= 4 * I_PL; \
        if (r < I_GU) { p0_matrix_item(args.in[24], 1024, 2816, args.in[23], (bf16*)(ws + WS_W2GU), 1, r, scr, lane); break; } r -= I_GU; \
        if (r < I_GU) { p0_matrix_item(args.in[25], 1024, 2816, args.in[23], (bf16*)(ws + WS_W2GU), 2, r, scr, lane); break; } r -= I_GU; \
        p0_matrix_item(args.in[26], 2816, 1024, nullptr, (bf16*)(ws + WS_W2D), 0, r, scr, lane); } while (0)
#define CONVERT_BY_SHORT_WGS(nwg_, first_, count_, excl_) do { const int rounds_ = ((nwg_) + G - 1) / G, c0_ = (nwg_) - (rounds_ - 1) * G, c1_ = G - (excl_); \
        if (bx >= c0_ && bx < c1_) { const int nw_ = (c1_ - c0_) * NWAVES; for (int it = (bx - c0_) * NWAVES + wave; it < (count_); it += nw_) CONVERT_ITEM((first_) + it); } } while (0)
    {   PHASE_IDS;
        {
            const float* xp = args.in[0]; const float* xs = args.in[1];
            for (int m = gw; m < MROWS / 2; m += NGW) { const int m2 = m + MROWS / 2;
                const float* sa = (m < MP) ? xp + (size_t)m * D : xs + (size_t)(m - MP) * D; const float* sb = (m2 < MP) ? xp + (size_t)m2 * D : xs + (size_t)(m2 - MP) * D;
                p0_row2(sa, XB + (size_t)m * D, ssq0 + (size_t)m * 4, sb, XB + (size_t)m2 * D, ssq0 + (size_t)m2 * 4, lane); }
            for (int m = gw; m < 512; m += NGW) p0_row2(args.in[7] + (size_t)m * D, (bf16*)(ws + WS_AMEM) + (size_t)m * D, ssqm + (size_t)m * 4,
                                                        args.in[7] + (size_t)(m + 512) * D, (bf16*)(ws + WS_AMEM) + (size_t)(m + 512) * D, ssqm + (size_t)(m + 512) * 4, lane);
            for (int m = MROWS + gw; m < MPAD; m += NGW) { GAS v4u* o = (GAS v4u*)(XB + (size_t)m * D) + lane; o[0] = (v4u){0u, 0u, 0u, 0u}; o[64] = (v4u){0u, 0u, 0u, 0u};
                if (lane == 0) { *(f32x4*)(ssq0 + (size_t)m * 4) = (f32x4){1024.f, 0.f, 0.f, 0.f}; } }
        }
        for (int it = gw; it < I_SET0; it += NGW) CONVERT_ITEM(it);
        for (int i = bx * 512 + tid; i < 3 * (MPAD - MP); i += G * 512) { const int k = i / (MPAD - MP), r = MP + i % (MPAD - MP); float* s = (k == 0) ? ssq1 : (k == 1) ? ssq2 : ssq3;
            *(f32x4*)(s + (size_t)r * 4) = (r < MROWS) ? (f32x4){0.f, 0.f, 0.f, 0.f} : (f32x4){1024.f, 0.f, 0.f, 0.f}; }
        for (int i = bx * 512 + tid; i < 3 * 129 * 4; i += G * 512) { const int h = i & 3, j = (i >> 2) % 129, g = (i >> 2) / 129; const int n = j << (2 * g);
            int bk = n; if (n >= 16) { bk = 16 + (int)(log((double)n / 16.0) / log(128.0) * 16.0); if (bk > 31) bk = 31; }
            ((float*)(ws + WS_BIAS))[i] = args.in[8][bk * 12 + g * 4 + h]; }
        for (int i = bx * 512 + tid; i < 3 * 4 * TAB_N; i += G * 512) { const int idx = i % TAB_N, h = (i / TAB_N) & 3, g = i / (4 * TAB_N); const int rel = 255 - idx; float v = MASKV;
            if (rel >= 0 && rel <= 128) { const int n = rel << (2 * g); int bk = n; if (n >= 16) { bk = 16 + (int)(log((double)n / 16.0) / log(128.0) * 16.0); if (bk > 31) bk = 31; }
                v = LOG2E * args.in[8][bk * 12 + g * 4 + h]; }
            ((float*)(ws + WS_BIAS2))[i] = v; }
    }
    GRID_BAR();

    {   PHASE_IDS;
        pg8::Gemm g{XB, (const bf16*)(ws + WS_W1GU), MPAD, 2 * DFF, D}; pg8::StaticOrder S; S.init(MPAD, 2 * DFF, G, bx);
        pg8::EpiGateUp E{HB, ssq0};
        pg8::gemm_phase<pg8::EpiGateUp, pg8::StaticOrder, false, true>(L, g, S, E);
        pg8::Gemm g2{(const bf16*)(ws + WS_AMEM), (const bf16*)(ws + WS_WMEM), 1024, 1024, D}; pg8::TailOrder S2{G - 16, 16, 4, bx};
        pg8::EpiMemKV E2{out + O_MKV, (bf16*)(ws + WS_MEMKV), ssqm};
        pg8::gemm_phase<pg8::EpiMemKV, pg8::TailOrder, true, true>(L, g2, S2, E2);
        CONVERT_BY_SHORT_WGS(65 * 22, I_SET0, I_SET1, 16);
    }
    GRID_BAR();

    {   PHASE_IDS;
        pg8::Gemm g{HB, (const bf16*)(ws + WS_W1D), MP, D, DFF}; pg8::StaticOrder S; S.init(MP, D, G, bx);
        pg8::EpiResid<false> E{XB, XB, ssq1, 0.5f};
        pg8::gemm_phase<pg8::EpiResid<false>, pg8::StaticOrder, false, true>(L, g, S, E);
    }
    GRID_BAR();

    {   PHASE_IDS;
        unsigned* const cs1 = (unsigned*)(ctl + CW_SMP);
        if (bx >= G - 32) { sample_resid<DFF>(L, HB + (size_t)MP * DFF, (const bf16*)(ws + WS_W1D), args.in[1], XB + (size_t)MP * D, ssq1 + (size_t)MP * 4, 0.5f, bx - (G - 32), tid, wave, lane); wg_publish(cs1, tid); }
        pg8::Gemm g{XB, (const bf16*)(ws + WS_WIN), MPAD, INCOLS, D}; pg8::GatedOrder S; S.init(MPAD, INCOLS, G, bx); S.cnt = cs1; S.need = 32u; S.gate_pm = 64;
        pg8::EpiWin E{(bf16*)(ws + WS_QKV), (bf16*)(ws + WS_Z), (bf16*)(ws + WS_QM), GB, ssq1, out};
        static_assert(pg8::EpiWin::o_w0p == O_W0P && pg8::EpiWin::o_pp == O_PP && pg8::EpiWin::o_w0s == O_W0S && pg8::EpiWin::o_ps == O_PS, "offsets");
        pg8::gemm_phase<pg8::EpiWin, pg8::GatedOrder, true, true>(L, g, S, E);
        CONVERT_BY_SHORT_WGS(65 * 25, I_SET0 + I_SET1, I_SET2, 0);
    }
    GRID_BAR();

    {   PHASE_IDS;
        {
            LAS unsigned char* vl = L + wave * 10752; LAS float* tabL = (LAS float*)(L + 86016); LAS float* xch = (LAS float*)(L + 91136) + wave * 32;
            const bf16* QKVp = (const bf16*)(ws + WS_QKV); const float* tab2 = (const float*)(ws + WS_BIAS2);
            for (int jg = vcu; jg < 256; jg += G) {
                const int J = jg * 8 + wave, b = J >> 9, hh = (J >> 7) & 3;
                __syncthreads();
                for (int i = tid; i < 3 * TAB_N + 64; i += NWAVES * 64) tabL[i] = (i < 3 * TAB_N) ? tab2[((i / TAB_N) * 4 + hh) * TAB_N + i % TAB_N] : MASKV;
                __syncthreads();
                attn_job(QKVp, (bf16*)(ws + WS_ABC), b, hh, (J >> 2) & 31, J & 3, vl, tabL, xch, lane);
                memattn_wg((const bf16*)(ws + WS_QM), (const bf16*)(ws + WS_MEMKV), (bf16*)(ws + WS_ABC) + 768, b, hh, J & 127, L, xch, tid, lane);
                __syncthreads();
                pool_job((const bf16*)(ws + WS_Z), (const bf16*)(ws + WS_WPOOL), args.in[16], (bf16*)(ws + WS_ABC) + 256, 32 * (J >> 2), J & 3, vl, lane);
            }
        }
        {
            LAS float* sx = (LAS float*)(L + 94208); LAS unsigned char* ptile = L + 102400;
            const int sp = bx - 128, ss = sp >> 2, sh = sp & 3;
            if (bx >= 128 && bx < 256) {
                if (wave < 3) sample_attn_group((const bf16*)(ws + WS_QKV) + (size_t)(MP + ss) * 2304, args.in[2 + wave], (const float*)(ws + WS_BIAS), ss, sh, wave, sx, lane);
                else if (wave < 7) sample_mem_quarter((const bf16*)(ws + WS_QM) + (size_t)(MP + ss) * 512, args.in[6], ss, sh, wave - 3, sx, lane);
            } else if (bx < 4) sample_pool_fill((const bf16*)(ws + WS_Z) + (size_t)MP * 512, args.in[5], bx, ptile, wave, lane);
            __syncthreads();
            if (bx >= 128 && bx < 256) sample_combine((bf16*)(ws + WS_ABC) + (size_t)(MP + ss) * KCAT, (bf16*)(ws + WS_ABC) + (size_t)(MP + ss) * KCAT + 768, sh, sx, wave, lane);
            else if (bx < 4 && wave == 0) pool_mma(ptile, (const bf16*)(ws + WS_WPOOL), args.in[16], (bf16*)(ws + WS_ABC) + 256, MP, bx, lane);
        }
    }
    GRID_BAR();

    {   PHASE_IDS;
        pg8::StaticOrder S; S.init(MP, D, G, bx);
        { pg8::Gemm g{(const bf16*)(ws + WS_ABC), (const bf16*)(ws + WS_WOA), MP, D, KCAT}; pg8::EpiMergeH E{GB, MB}; pg8::gemm_phase<pg8::EpiMergeH, pg8::StaticOrder, false, true>(L, g, S, E); }
    }
    GRID_BAR();

    {   PHASE_IDS;
        pg8::Gemm g{MB, (const bf16*)(ws + WS_WOUT), MP, D, D}; pg8::StaticOrder S; S.init(MP, D, G, bx);
        pg8::EpiResid<false> E{XB, XB, ssq2, 1.0f};
        pg8::gemm_phase<pg8::EpiResid<false>, pg8::StaticOrder, false, true>(L, g, S, E);
    }
    GRID_BAR();

    {   PHASE_IDS;
        unsigned* const cs2 = (unsigned*)(ctl + CW_SMP + 64); unsigned* const cs3 = (unsigned*)(ctl + CW_SMP + 128);
        if (bx >= G - 32) { const int ct = bx - (G - 32);
            float mv[2] = {0.f, 0.f};
            { mini_gemm32<256>(L, (const bf16*)(ws + WS_ABC) + (size_t)MP * KCAT, (const bf16*)(ws + WS_WOA), 32 * ct, wave, lane, KCAT, KCAT);
#pragma unroll
              for (int i = 0; i < 2; ++i) { int row, col; const float v = mini_elem(L, tid, i, row, col); mv[i] += (float)GB[(size_t)(MP + row) * 3072 + 32 * ct + col] * (1.0f / 255.0f) * v; }
              __syncthreads(); }
#pragma unroll
            for (int b = 1; b < 3; ++b) { const int ko = (b == 1) ? 256 : 768;
                mini_gemm32<512>(L, (const bf16*)(ws + WS_ABC) + (size_t)MP * KCAT + ko, (const bf16*)(ws + WS_WOA) + ko, 32 * ct, wave, lane, KCAT, KCAT);
#pragma unroll
                for (int i = 0; i < 2; ++i) { int row, col; const float v = mini_elem(L, tid, i, row, col); mv[i] += (float)GB[(size_t)(MP + row) * 3072 + b * 1024 + 32 * ct + col] * (1.0f / 255.0f) * v; }
                __syncthreads(); }
#pragma unroll
            for (int i = 0; i < 2; ++i) { const int r = (tid >> 6) + 8 * i, l = tid & 63, row = (r & 3) + 8 * (r >> 2) + 4 * (l >> 5), col = l & 31; MB[(size_t)(MP + row) * 1024 + 32 * ct + col] = (bf16)f2bf(mv[i]); }
            wg_publish(cs2, tid); wg_wait(cs2, 32u, tid);
            sample_resid<D>(L, MB + (size_t)MP * D, (const bf16*)(ws + WS_WOUT), nullptr, XB + (size_t)MP * D, ssq2 + (size_t)MP * 4, 1.0f, ct, tid, wave, lane);
            wg_publish(cs3, tid);
        }
        pg8::Gemm g{XB, (const bf16*)(ws + WS_W2GU), MPAD, 2 * DFF, D}; pg8::GatedOrder S; S.init(MPAD, 2 * DFF, G, bx); S.cnt = cs3; S.need = 32u; S.gate_pm = 64;
        pg8::EpiGateUp E{HB, ssq2};
        pg8::gemm_phase<pg8::EpiGateUp, pg8::GatedOrder, false, true>(L, g, S, E);
    }
    GRID_BAR();

    {   PHASE_IDS;
        pg8::Gemm g{HB, (const bf16*)(ws + WS_W2D), MP, D, DFF}; pg8::StaticOrder S; S.init(MP, D, G, bx);
        pg8::EpiFinal E{XB, out, args.in[27], ssq3, (unsigned*)(ctl + CW_FIN), 0.5f};
        pg8::gemm_phase<pg8::EpiFinal, pg8::StaticOrder, false, true>(L, g, S, E);
        if (bx < 32) sample_final<DFF>(L, HB + (size_t)MP * DFF, (const bf16*)(ws + WS_W2D), XB + (size_t)MP * D, out + (size_t)MP * D, args.in[27], ssq3 + (size_t)MP * 4, (unsigned*)(ctl + CW_FINS), 0.5f, bx, tid, wave, lane);
    }
}

extern "C" void kernel_launch(void* const* d_in, const int* in_sizes, int n_in, void* d_out, int out_size, void* d_ws, size_t ws_size, hipStream_t stream) {
    static int grid = 0;
    if (grid == 0) {
        if (n_in != 28 || out_size != (int)O_END || ws_size < WS_END) { fprintf(stderr, "kernel_launch: unexpected shapes: n_in %d out %d (want %zu) ws %zu (want %zu)\n", n_in, out_size, (size_t)O_END, ws_size, (size_t)WS_END); grid = -1; return; }
        int dev = 0, cus = 0;
        if (hipGetDevice(&dev) != hipSuccess || hipDeviceGetAttribute(&cus, hipDeviceAttributeMultiprocessorCount, dev) != hipSuccess) { grid = -1; return; }
        if (hipFuncSetAttribute((const void*)fwd_kernel, hipFuncAttributeMaxDynamicSharedMemorySize, LDS_BYTES) != hipSuccess) { fprintf(stderr, "kernel_launch: hipFuncSetAttribute failed\n"); grid = -1; return; }
        int per_cu = 0;
        if (hipOccupancyMaxActiveBlocksPerMultiprocessor(&per_cu, (const void*)fwd_kernel, NWAVES * 64, LDS_BYTES) != hipSuccess || per_cu < 1) fprintf(stderr, "kernel_launch: occupancy query reports %d\n", per_cu);
        (void)hipGetLastError();
        grid = cus;
        if (grid != 256) fprintf(stderr, "kernel_launch: built for 256 CUs, device has %d\n", grid);
    }
    if (grid < 0) return;
    if (hipMemsetAsync((char*)d_ws + WS_CTL, 0, CTL_ZERO_BYTES, stream) != hipSuccess) return;
    Args a{};
    for (int i = 0; i < 28; ++i) a.in[i] = (const float*)d_in[i];
    a.out = (float*)d_out; a.ws = (unsigned char*)d_ws;
    hipLaunchKernelGGL(fwd_kernel, dim3(grid), dim3(NWAVES * 64), LDS_BYTES, stream, a);
}
```

```cpp
#include <hip/hip_runtime.h>
#include <cstdio>
#include <cstdint>
#include <cmath>
namespace pg8 {
#define PG8_LAS __attribute__((address_space(3)))
typedef unsigned short bf16_t;
typedef short bf16x8 __attribute__((ext_vector_type(8)));
typedef float f32x4 __attribute__((ext_vector_type(4)));
typedef unsigned u32x4 __attribute__((ext_vector_type(4)));
constexpr int BM = 256, BK = 64, HALF = 128, HTB = HALF * BK * 2  , STAGE_BYTES = 8 * HTB, NXCD = 8, WGM = 8, AUX_OFF = STAGE_BYTES + 1024;

__host__ __device__ __forceinline__ int lds_byte(int r, int c) { const int st = (r >> 4) * 2 + (c >> 5), rr = r & 15, cc = c & 31, ob = rr * 64 + cc * 2; return st * 1024 + (ob ^ (((ob >> 9) & 1) << 5)); }
__host__ __device__ __forceinline__ void stage_rc(int b, int& R, int& C) { const int st = b / 1024, sb = b % 1024, swz = sb ^ (((sb >> 9) & 1) << 5); R = (st >> 1) * 16 + swz / 64; C = (st & 1) * 32 + (swz % 64) / 2; }
__host__ __device__ __forceinline__ int perm32(int rho) { const int n = rho >> 4, i = rho & 15; return 8 * (i >> 2) + 4 * n + (i & 3); }

struct Unit { int pm, pn; };
struct Gemm { const bf16_t* A; const bf16_t* Bt; int M, N, K; };

struct StaticOrder {
    int nM, nN, nwg, G, c;
    __host__ __device__ void init(int M, int N, int G_, int c_) { nM = M / BM; nN = N / BM; nwg = nM * nN; G = G_; c = c_; }
    __host__ __device__ bool next(int i, Unit& u) const {
        const long L = (long)i * G + c; if (L >= nwg) return false;
        int wgid = (int)L; { const int q = nwg / NXCD, r = nwg % NXCD, xcd = wgid % NXCD, off = wgid / NXCD; wgid = (xcd < r ? xcd * (q + 1) : r * (q + 1) + (xcd - r) * q) + off; }
        const int nig = WGM * nN, gid = wgid / nig, fm = gid * WGM, gsz = (nM - fm) < WGM ? (nM - fm) : WGM;
        u.pm = fm + ((wgid % nig) % gsz); u.pn = (wgid % nig) / gsz; return true;
    }
    __device__ __forceinline__ void a_ready(const Unit&) const {}
    __device__ __forceinline__ void done(const Unit&) const {}
};

typedef float f32x2_t __attribute__((ext_vector_type(2))); typedef __bf16 bf16x2_t __attribute__((ext_vector_type(2)));
__device__ __forceinline__ unsigned cvt_pk_bf16(float lo, float hi) { const f32x2_t v = {lo, hi}; const bf16x2_t b = __builtin_convertvector(v, bf16x2_t); return __builtin_bit_cast(unsigned, b); }
typedef float f32x2 __attribute__((ext_vector_type(2)));

constexpr int P_MP = 16384, P_MROWS = 16416, P_DFF = 2816;
__device__ __forceinline__ float row_rinv(const float* ssq, int row) { const f32x4 s = *(const f32x4*)(ssq + (size_t)row * 4); return rsqrtf(((s[0] + s[1]) + (s[2] + s[3])) * (1.0f / 1024.0f) + 1e-6f); }
__device__ __forceinline__ float aux_rinv(const PG8_LAS unsigned char* aux, int lrow) { const f32x4 s = *(const PG8_LAS f32x4*)(aux + lrow * 16); return rsqrtf(((s[0] + s[1]) + (s[2] + s[3])) * (1.0f / 1024.0f) + 1e-6f); }
__device__ __forceinline__ void prep_ssq(const float* ssq, PG8_LAS unsigned char* aux, const Unit& u, int wid, int lane) {
    if (wid < 4) __builtin_amdgcn_global_load_lds((const unsigned*)(ssq + (size_t)(u.pm * BM + wid * 64 + lane) * 4), (PG8_LAS unsigned*)(aux + wid * 1024), 16, 0, 0);
}
__device__ __forceinline__ float fast_sigmoid(float v) { return __builtin_amdgcn_rcpf(1.0f + __builtin_amdgcn_exp2f(v * -1.4426950408889634f)); }
__device__ __forceinline__ u32x4 pack8(const f32x4 a, const f32x4 b) { u32x4 w; w.x = cvt_pk_bf16(a[0], a[1]); w.y = cvt_pk_bf16(a[2], a[3]); w.z = cvt_pk_bf16(b[0], b[1]); w.w = cvt_pk_bf16(b[2], b[3]); return w; }
typedef unsigned u32x2 __attribute__((ext_vector_type(2)));
__device__ __forceinline__ float u8f(unsigned w, int k) { return (float)((w >> (8 * k)) & 0xffu); }
__device__ __forceinline__ float bf_lo(unsigned w) { return __uint_as_float(w << 16); }
__device__ __forceinline__ float bf_hi(unsigned w) { return __uint_as_float(w & 0xffff0000u); }

struct EpiGateUp {
    static constexpr bool PERM = true, AFTER_DRAIN = false, PREP = true, KHOOK = false;
    bf16_t* H; const float* ssq;
    __device__ __forceinline__ void prep(PG8_LAS unsigned char* aux, const Unit& u, int wid, int lane) const { prep_ssq(ssq, aux, u, wid, lane); }
    __device__ __forceinline__ void operator()(const f32x4 (&acc)[2][2][4][2], const Unit& u, int wr, int wc, int fr, int fq, const PG8_LAS unsigned char* aux) const {
        const int row0 = u.pm * BM + wr * 64 + fr, col0 = u.pn * HALF + wc * 32 + 8 * fq;
#pragma unroll
        for (int ai = 0; ai < 2; ++ai)
#pragma unroll
            for (int m = 0; m < 4; ++m) { const int row = row0 + ai * HALF + m * 16; const float ri = aux_rinv(aux, ai * HALF + wr * 64 + m * 16 + fr);
                f32x4 hv[2];
#pragma unroll
                for (int n = 0; n < 2; ++n) { const f32x4 g = acc[ai][0][m][n] * ri, up = acc[ai][1][m][n] * ri;
#pragma unroll
                    for (int j = 0; j < 4; ++j) hv[n][j] = g[j] * fast_sigmoid(g[j]) * up[j]; }
                *(u32x4*)(H + (size_t)row * P_DFF + col0) = pack8(hv[0], hv[1]); }
    }
};

struct EpiWin {
    static constexpr bool PERM = true, AFTER_DRAIN = false, PREP = true, KHOOK = false;
    bf16_t* QKV; bf16_t* Z; bf16_t* QM; unsigned char* G; const float* ssq; float* out;
    __device__ __forceinline__ void prep(PG8_LAS unsigned char* aux, const Unit& u, int wid, int lane) const { prep_ssq(ssq, aux, u, wid, lane); }
    static constexpr size_t o_w0p = (size_t)P_MROWS * 1024, o_pp = o_w0p + 262144 + 1048576 + 4194304, o_w0s = o_pp + 30720 + 1048576, o_ps = o_w0s + 3 * 16384;
    __device__ __forceinline__ void operator()(const f32x4 (&acc)[2][2][4][2], const Unit& u, int wr, int wc, int fr, int fq, const PG8_LAS unsigned char* aux) const {
        const int row0 = u.pm * BM + wr * 64 + fr, pn = u.pn;
#pragma unroll
        for (int ai = 0; ai < 2; ++ai)
#pragma unroll
            for (int m = 0; m < 4; ++m) { const int row = row0 + ai * HALF + m * 16; if (row >= P_MROWS) continue; const float ri = aux_rinv(aux, ai * HALF + wr * 64 + m * 16 + fr);
#pragma unroll
                for (int bj = 0; bj < 2; ++bj) { const int cl = bj * HALF + wc * 32 + 8 * fq;
                    f32x4 v0 = acc[ai][bj][m][0] * ri, v1 = acc[ai][bj][m][1] * ri;
                    if (pn < 9) {
                        if (pn >= 3) {
                            const int g = pn % 3, kv = (pn >= 6) ? 1 : 0, W = (g == 0) ? 128 : (g == 1) ? 512 : 2048; const size_t owp = o_w0p + (g >= 1 ? 262144u : 0u) + (g >= 2 ? 1048576u : 0u), ows = o_w0s + (size_t)g * 16384;
                            float* dst = nullptr;
                            if (row < P_MP) { const int b = row >> 12, t = row & 4095; if (t >= 4096 - W) dst = out + owp + ((size_t)(b * W + (t - (4096 - W))) * 2 + kv) * 256 + cl; }
                            else dst = out + ows + ((size_t)(row - P_MP) * 2 + kv) * 256 + cl;
                            if (dst) { *(f32x4*)dst = v0; *(f32x4*)(dst + 4) = v1; }
                        } else { v0 = v0 * 0.125f; v1 = v1 * 0.125f; }
                        *(u32x4*)(QKV + (size_t)row * 2304 + pn * 256 + cl) = pack8(v0, v1);
                    } else if (pn < 11) {
                        const int c = (pn - 9) * 256 + cl; *(u32x4*)(Z + (size_t)row * 512 + c) = pack8(v0, v1);
                        float* dst = nullptr;
                        if (row < P_MP) { const int b = row >> 12, t = row & 4095; if (t >= 4096 - 15) dst = out + o_pp + (size_t)(b * 15 + (t - (4096 - 15))) * 512 + c; }
                        else dst = out + o_ps + (size_t)(row - P_MP) * 512 + c;
                        if (dst) { *(f32x4*)dst = v0; *(f32x4*)(dst + 4) = v1; }
                    } else if (pn < 13) {
                        const float sc = 0.08838834764831845f; v0 = v0 * sc; v1 = v1 * sc;
                        *(u32x4*)(QM + (size_t)row * 512 + (pn - 11) * 256 + cl) = pack8(v0, v1);
                    } else {
#pragma unroll
                        for (int j = 0; j < 4; ++j) { v0[j] = fmaxf(fast_sigmoid(v0[j]) * 255.0f + 0.5f, 1.0f); v1[j] = fmaxf(fast_sigmoid(v1[j]) * 255.0f + 0.5f, 1.0f); }
                        u32x2 gb; gb.x = (unsigned)v0[0] | ((unsigned)v0[1] << 8) | ((unsigned)v0[2] << 16) | ((unsigned)v0[3] << 24); gb.y = (unsigned)v1[0] | ((unsigned)v1[1] << 8) | ((unsigned)v1[2] << 16) | ((unsigned)v1[3] << 24);
                        *(u32x2*)(G + (size_t)row * 3072 + (pn - 13) * 256 + cl) = gb;
                    } } }
    }
};

struct EpiMemKV {
    static constexpr bool PERM = true, AFTER_DRAIN = false, PREP = true, KHOOK = false;
    float* out; bf16_t* KVb; const float* ssq;
    __device__ __forceinline__ void prep(PG8_LAS unsigned char* aux, const Unit& u, int wid, int lane) const { prep_ssq(ssq, aux, u, wid, lane); }
    __device__ __forceinline__ void operator()(const f32x4 (&acc)[2][2][4][2], const Unit& u, int wr, int wc, int fr, int fq, const PG8_LAS unsigned char* aux) const {
        const int row0 = u.pm * BM + wr * 64 + fr;
#pragma unroll
        for (int ai = 0; ai < 2; ++ai)
#pragma unroll
            for (int m = 0; m < 4; ++m) { const int row = row0 + ai * HALF + m * 16; const float ri = aux_rinv(aux, ai * HALF + wr * 64 + m * 16 + fr);
#pragma unroll
                for (int bj = 0; bj < 2; ++bj) { const int col = u.pn * BM + bj * HALF + wc * 32 + 8 * fq; const f32x4 v0 = acc[ai][bj][m][0] * ri, v1 = acc[ai][bj][m][1] * ri;
                    float* dst = out + (size_t)row * 1024 + col; *(f32x4*)dst = v0; *(f32x4*)(dst + 4) = v1;
                    *(u32x4*)(KVb + (size_t)row * 1024 + col) = pack8(v0, v1); } }
    }
};

struct EpiMergeH {
    static constexpr bool PERM = true, AFTER_DRAIN = false, PREP = false, KHOOK = true;
    static constexpr int KT1 = 4, KT2 = 12;
    const unsigned char* G; bf16_t* Mb;
    __device__ __forceinline__ void khook(f32x4 (&acc)[2][2][4][2], const Unit& u, int t, int wr, int wc, int fr, int fq) const {
        const unsigned char* Gn = G + (t == KT1 ? 0 : 1024) + (size_t)(u.pm * BM) * 3072 + u.pn * BM;
        const unsigned lo = (unsigned)(wr * 64 + fr) * 3072u + (unsigned)(wc * 32 + 8 * fq);
#pragma unroll
        for (int ai = 0; ai < 2; ++ai)
#pragma unroll
            for (int mh = 0; mh < 2; ++mh) {
                u32x2 gn[2][2], gd[2][2];
#pragma unroll
                for (int mm = 0; mm < 2; ++mm)
#pragma unroll
                    for (int bj = 0; bj < 2; ++bj) { const unsigned o = lo + (unsigned)((ai * HALF + (2 * mh + mm) * 16) * 3072 + bj * HALF); gn[mm][bj] = *(const u32x2*)(Gn + o); gd[mm][bj] = *(const u32x2*)(Gn + 1024 + o); }
                asm volatile("" ::: "memory");
#pragma unroll
                for (int mm = 0; mm < 2; ++mm)
#pragma unroll
                    for (int bj = 0; bj < 2; ++bj) { const u32x2 a = gn[mm][bj], b = gd[mm][bj]; const int m = 2 * mh + mm;
#pragma unroll
                        for (int j = 0; j < 4; ++j) { acc[ai][bj][m][0][j] *= u8f(a.x, j) * __builtin_amdgcn_rcpf(u8f(b.x, j)); acc[ai][bj][m][1][j] *= u8f(a.y, j) * __builtin_amdgcn_rcpf(u8f(b.y, j)); } }
                asm volatile("" ::: "memory");
            }
    }
    __device__ __forceinline__ void operator()(const f32x4 (&acc)[2][2][4][2], const Unit& u, int wr, int wc, int fr, int fq, const PG8_LAS unsigned char*) const {
        const int row0 = u.pm * BM + wr * 64 + fr;
#pragma unroll
        for (int ai = 0; ai < 2; ++ai) {
            u32x2 gw[4][2];
#pragma unroll
            for (int m = 0; m < 4; ++m)
#pragma unroll
                for (int bj = 0; bj < 2; ++bj) gw[m][bj] = *(const u32x2*)(G + 2048 + (size_t)(row0 + ai * HALF + m * 16) * 3072 + u.pn * BM + bj * HALF + wc * 32 + 8 * fq);
            asm volatile("" ::: "memory");
#pragma unroll
            for (int m = 0; m < 4; ++m)
#pragma unroll
                for (int bj = 0; bj < 2; ++bj) { const size_t row = row0 + ai * HALF + m * 16; const int col = u.pn * BM + bj * HALF + wc * 32 + 8 * fq; const u32x2 g = gw[m][bj]; const float k255 = 1.0f / 255.0f;
                    f32x4 v0 = acc[ai][bj][m][0] * k255, v1 = acc[ai][bj][m][1] * k255;
#pragma unroll
                    for (int j = 0; j < 4; ++j) { v0[j] *= u8f(g.x, j); v1[j] *= u8f(g.y, j); }
                    *(u32x4*)(Mb + row * 1024 + col) = pack8(v0, v1); }
            asm volatile("" ::: "memory");
        }
    }
};

__device__ __forceinline__ void unpack8(const u32x4 w, f32x4& a, f32x4& b) { a[0] = bf_lo(w.x); a[1] = bf_hi(w.x); a[2] = bf_lo(w.y); a[3] = bf_hi(w.y); b[0] = bf_lo(w.z); b[1] = bf_hi(w.z); b[2] = bf_lo(w.w); b[3] = bf_hi(w.w); }
template <bool BASE_F32>
struct EpiResid {
    static constexpr bool PERM = true, AFTER_DRAIN = true, PREP = false, KHOOK = false;
    const void* base; bf16_t* xb; float* ssq_out; float scale;
    __device__ __forceinline__ void fused(f32x4 (&acc)[2][2][4][2], const Unit& u, int wr, int wc, int fr, int fq, PG8_LAS unsigned char* lds, int wid, int lane) const {
        PG8_LAS float* P = (PG8_LAS float*)lds;
        const int row0 = u.pm * BM + wr * 64 + fr;
        u32x4 raw[2][4][2];
        if (!BASE_F32) {
#pragma unroll
            for (int ai = 0; ai < 2; ++ai)
#pragma unroll
                for (int m = 0; m < 4; ++m)
#pragma unroll
                    for (int bj = 0; bj < 2; ++bj) raw[ai][m][bj] = *(const u32x4*)((const bf16_t*)base + (size_t)(row0 + ai * HALF + m * 16) * 1024 + u.pn * BM + bj * HALF + wc * 32 + 8 * fq);
            asm volatile("" ::: "memory");
        }
#pragma unroll
        for (int ai = 0; ai < 2; ++ai) {
            f32x4 pre[4][2][2];
#pragma unroll
            for (int m = 0; m < 4; ++m)
#pragma unroll
                for (int bj = 0; bj < 2; ++bj) { const size_t off = (size_t)(row0 + ai * HALF + m * 16) * 1024 + u.pn * BM + bj * HALF + wc * 32 + 8 * fq;
                    if (BASE_F32) { pre[m][bj][0] = *(const f32x4*)((const float*)base + off); pre[m][bj][1] = *(const f32x4*)((const float*)base + off + 4); }
                    else unpack8(raw[ai][m][bj], pre[m][bj][0], pre[m][bj][1]); }
            asm volatile("" ::: "memory");
#pragma unroll
            for (int m = 0; m < 4; ++m) { const int row = row0 + ai * HALF + m * 16; float s = 0.f;
#pragma unroll
                for (int bj = 0; bj < 2; ++bj) { const int col = u.pn * BM + bj * HALF + wc * 32 + 8 * fq; const size_t off = (size_t)row * 1024 + col;
                    const f32x4 v0 = pre[m][bj][0] + acc[ai][bj][m][0] * scale, v1 = pre[m][bj][1] + acc[ai][bj][m][1] * scale;
                    *(u32x4*)(xb + off) = pack8(v0, v1);
                    s += (v0[0] * v0[0] + v0[1] * v0[1]) + (v0[2] * v0[2] + v0[3] * v0[3]) + (v1[0] * v1[0] + v1[1] * v1[1]) + (v1[2] * v1[2] + v1[3] * v1[3]); }
                s += __shfl_xor(s, 16); s += __shfl_xor(s, 32);
                if (fq == 0) P[(ai * HALF + wr * 64 + m * 16 + fr) * 4 + wc] = s; }
            asm volatile("" ::: "memory"); }
        asm volatile("s_waitcnt lgkmcnt(0)" ::: "memory"); __builtin_amdgcn_s_barrier(); asm volatile("" ::: "memory");
        const int tid = wid * 64 + lane;
        if (tid < 256) { const f32x4 p = *(const PG8_LAS f32x4*)(P + tid * 4); ssq_out[(size_t)(u.pm * BM + tid) * 4 + u.pn] = (p[0] + p[1]) + (p[2] + p[3]); }
        asm volatile("s_waitcnt lgkmcnt(0)" ::: "memory"); __builtin_amdgcn_s_barrier(); asm volatile("" ::: "memory");
    }
};
struct EpiFinal {
    static constexpr bool PERM = true, AFTER_DRAIN = true, PREP = false, KHOOK = false;
    const bf16_t* base; float* out; const float* gfin; float* xbuf; unsigned* cnt; float scale;
    __device__ __forceinline__ void fused(f32x4 (&acc)[2][2][4][2], const Unit& u, int wr, int wc, int fr, int fq, PG8_LAS unsigned char* lds, int wid, int lane) const {
        PG8_LAS float* P = (PG8_LAS float*)lds;
        PG8_LAS float* S = (PG8_LAS float*)(lds + 4096);
        const int row0 = u.pm * BM + wr * 64 + fr;
#pragma unroll
        for (int ai = 0; ai < 2; ++ai) {
            f32x4 pre[4][2][2];
#pragma unroll
            for (int m = 0; m < 4; ++m)
#pragma unroll
                for (int bj = 0; bj < 2; ++bj) { const size_t off = (size_t)(row0 + ai * HALF + m * 16) * 1024 + u.pn * BM + bj * HALF + wc * 32 + 8 * fq; unpack8(*(const u32x4*)(base + off), pre[m][bj][0], pre[m][bj][1]); }
            asm volatile("" ::: "memory");
#pragma unroll
            for (int m = 0; m < 4; ++m) { const int row = row0 + ai * HALF + m * 16; float s = 0.f; (void)row;
#pragma unroll
                for (int bj = 0; bj < 2; ++bj) {
                    const f32x4 v0 = pre[m][bj][0] + acc[ai][bj][m][0] * scale, v1 = pre[m][bj][1] + acc[ai][bj][m][1] * scale;
                    acc[ai][bj][m][0] = v0; acc[ai][bj][m][1] = v1;
                    s += (v0[0] * v0[0] + v0[1] * v0[1]) + (v0[2] * v0[2] + v0[3] * v0[3]) + (v1[0] * v1[0] + v1[1] * v1[1]) + (v1[2] * v1[2] + v1[3] * v1[3]); }
                s += __shfl_xor(s, 16); s += __shfl_xor(s, 32);
                if (fq == 0) P[(ai * HALF + wr * 64 + m * 16 + fr) * 4 + wc] = s; }
            asm volatile("" ::: "memory"); }
        asm volatile("s_waitcnt lgkmcnt(0)" ::: "memory"); __builtin_amdgcn_s_barrier(); asm volatile("" ::: "memory");
        const int tid = wid * 64 + lane;
        if (tid < 256) { const f32x4 p = *(const PG8_LAS f32x4*)(P + tid * 4);
            __hip_atomic_store(xbuf + (size_t)(u.pm * BM + tid) * 4 + u.pn, (p[0] + p[1]) + (p[2] + p[3]), __ATOMIC_RELAXED, __HIP_MEMORY_SCOPE_AGENT); }
        asm volatile("s_waitcnt vmcnt(0)" ::: "memory");
        if (lane == 0) __hip_atomic_fetch_add(cnt + 64 * u.pm, 1u, __ATOMIC_RELAXED, __HIP_MEMORY_SCOPE_AGENT);
        if (wid == 0) {
            unsigned sp = 0;
            while ((unsigned)__builtin_amdgcn_readfirstlane(__hip_atomic_load(cnt + 64 * u.pm, __ATOMIC_RELAXED, __HIP_MEMORY_SCOPE_AGENT)) < 32u) { __builtin_amdgcn_s_sleep(1); if (++sp > (1u << 24)) break; }
        }
        asm volatile("s_waitcnt vmcnt(0) lgkmcnt(0)" ::: "memory"); __builtin_amdgcn_s_barrier(); asm volatile("" ::: "memory");
        if (tid < 256) { const float* xp = xbuf + (size_t)(u.pm * BM + tid) * 4;
            const float a = __hip_atomic_load(xp, __ATOMIC_RELAXED, __HIP_MEMORY_SCOPE_AGENT), b = __hip_atomic_load(xp + 1, __ATOMIC_RELAXED, __HIP_MEMORY_SCOPE_AGENT),
                        c = __hip_atomic_load(xp + 2, __ATOMIC_RELAXED, __HIP_MEMORY_SCOPE_AGENT), d = __hip_atomic_load(xp + 3, __ATOMIC_RELAXED, __HIP_MEMORY_SCOPE_AGENT);
            S[tid] = rsqrtf(((a + b) + (c + d)) * (1.0f / 1024.0f) + 1e-6f); }
        asm volatile("s_waitcnt vmcnt(0) lgkmcnt(0)" ::: "memory"); __builtin_amdgcn_s_barrier(); asm volatile("" ::: "memory");
#pragma unroll
        for (int bj = 0; bj < 2; ++bj) { const int col = u.pn * BM + bj * HALF + wc * 32 + 8 * fq; const f32x4 g0 = *(const f32x4*)(gfin + col), g1 = *(const f32x4*)(gfin + col + 4);
#pragma unroll
            for (int ai = 0; ai < 2; ++ai)
#pragma unroll
                for (int m = 0; m < 4; ++m) { const int lr = ai * HALF + wr * 64 + m * 16 + fr; const float ri = S[lr]; const size_t off = (size_t)(u.pm * BM + lr) * 1024 + col;
                    *(f32x4*)(out + off) = acc[ai][bj][m][0] * ri * g0; *(f32x4*)(out + off + 4) = acc[ai][bj][m][1] * ri * g1; } }
        asm volatile("s_waitcnt lgkmcnt(0)" ::: "memory"); __builtin_amdgcn_s_barrier(); asm volatile("" ::: "memory");
    }
};
struct TailOrder {
    int first, count, nN, c;
    __device__ bool next(int i, Unit& u) const { const int idx = c - first; if (i != 0 || idx < 0 || idx >= count) return false; u.pm = idx / nN; u.pn = idx % nN; return true; }
    __device__ __forceinline__ void a_ready(const Unit&) const {}
    __device__ __forceinline__ void done(const Unit&) const {}
};

struct GatedOrder : StaticOrder {
    const unsigned* cnt; unsigned need; int gate_pm;
    __device__ __forceinline__ void a_ready(const Unit& u) const {
        if (u.pm != gate_pm) return;
        if (threadIdx.x < 64) {
            unsigned sp = 0;
            while ((unsigned)__builtin_amdgcn_readfirstlane(__hip_atomic_load(cnt, __ATOMIC_RELAXED, __HIP_MEMORY_SCOPE_AGENT)) < need) { __builtin_amdgcn_s_sleep(2); if (++sp > (1u << 24)) break; }
            __builtin_amdgcn_fence(__ATOMIC_ACQUIRE, "agent");
            asm volatile("s_waitcnt vmcnt(0)" ::: "memory");
        }
        asm volatile("" ::: "memory"); __builtin_amdgcn_s_barrier(); asm volatile("" ::: "memory");
    }
};
template <class Epi, class Sched, bool ALIGN_EPI = false, bool SP2 = false>
__device__ __forceinline__ void gemm_phase(PG8_LAS unsigned char* lds, const Gemm g, const Sched& S, const Epi& E) {
    int tid_ = threadIdx.x; asm volatile("" : "+v"(tid_));
    const int tid = tid_, wid = __builtin_amdgcn_readfirstlane(tid >> 6), lane = tid & 63, wr = wid >> 2, wc = wid & 3, fr = lane & 15, fq = lane >> 4;
    const int K = g.K, nt = K / BK;
    unsigned voffA[2], voffB[2];
#pragma unroll
    for (int i = 0; i < 2; ++i) { int R, C; stage_rc(tid * 16 + i * 8192, R, C); const int Rb = Epi::PERM ? ((R & ~31) + perm32(R & 31)) : R;
        voffA[i] = (unsigned)(R * K + C) * 2u; voffB[i] = (unsigned)(Rb * K + C) * 2u; }
    const size_t kstep = (size_t)(BK * 2);
    const size_t hstep = (size_t)HALF * K * 2;
    const size_t tstep = 2 * hstep;
    const unsigned ldsw = (unsigned)wid * 1024u;
    const int aoff = lds_byte(wr * 64 + fr, fq * 8), boff = lds_byte(wc * 32 + fr, fq * 8);
#define PG8_SA(b, h) (((b) * 2 + (h)) * HTB)
#define PG8_SB(b, h) ((4 + (b) * 2 + (h)) * HTB)
#define PG8_STAGE(bufoff, gbase, voff) do { _Pragma("unroll") for (int _i = 0; _i < 2; ++_i) \
        __builtin_amdgcn_global_load_lds((const unsigned*)((const char*)(gbase) + (voff)[_i]), (PG8_LAS unsigned*)(lds + (bufoff) + ldsw + _i * 8192), 16, 0, 0); } while (0)
#define PG8_LDA(dst, b, h) do { _Pragma("unroll") for (int m = 0; m < 4; ++m) _Pragma("unroll") for (int k = 0; k < 2; ++k) dst[m][k] = *(const PG8_LAS bf16x8*)(lds + PG8_SA(b, h) + aoff + m * 2048 + k * 1024); } while (0)
#define PG8_LDB(dst, b, h) do { _Pragma("unroll") for (int n = 0; n < 2; ++n) _Pragma("unroll") for (int k = 0; k < 2; ++k) dst[n][k] = *(const PG8_LAS bf16x8*)(lds + PG8_SB(b, h) + boff + n * 2048 + k * 1024); } while (0)
#define PG8_MMA(ai, bj, At, Bt) do { __builtin_amdgcn_s_setprio(1); _Pragma("unroll") for (int m = 0; m < 4; ++m) _Pragma("unroll") for (int n = 0; n < 2; ++n) _Pragma("unroll") for (int k = 0; k < 2; ++k) \
        acc[ai][bj][m][n] = __builtin_amdgcn_mfma_f32_16x16x32_bf16(Bt[n][k], At[m][k], acc[ai][bj][m][n], 0, 0, 0); __builtin_amdgcn_s_setprio(0); } while (0)
#define PG8_WAIT_V(n) asm volatile("s_waitcnt vmcnt(" #n ")" ::: "memory")
#define PG8_WAIT_L(n) asm volatile("s_waitcnt lgkmcnt(" #n ")" ::: "memory")
#define PG8_BAR __builtin_amdgcn_s_barrier()
#define PG8_SCHED __builtin_amdgcn_sched_barrier(0)
    Unit cur, nxt; int ui = 0;
    if (!S.next(0, cur)) return;
    f32x4 acc[2][2][4][2];
#pragma unroll
    for (int a = 0; a < 2; ++a)
#pragma unroll
        for (int b = 0; b < 2; ++b)
#pragma unroll
            for (int m = 0; m < 4; ++m)
#pragma unroll
                for (int n = 0; n < 2; ++n) acc[a][b][m][n] = (f32x4){0.f, 0.f, 0.f, 0.f};
    bf16x8 At[4][2], B0[2][2], B1[2][2];
    const char* cA = (const char*)g.A + (size_t)cur.pm * tstep; const char* cB = (const char*)g.Bt + (size_t)cur.pn * tstep;
    S.a_ready(cur);
    PG8_LAS unsigned char* const auxb = lds + AUX_OFF;
    if constexpr (Epi::PREP) E.prep(auxb, cur, wid, lane);
    if constexpr (SP2) {
        PG8_STAGE(PG8_SB(0, 0), cB, voffB); PG8_STAGE(PG8_SB(0, 1), cB + hstep, voffB); PG8_STAGE(PG8_SA(0, 0), cA, voffA); PG8_STAGE(PG8_SA(0, 1), cA + hstep, voffA);
        if (wr == 1) PG8_BAR;
        PG8_WAIT_V(2); PG8_BAR;
        PG8_STAGE(PG8_SB(1, 0), cB + kstep, voffB); PG8_STAGE(PG8_SA(1, 0), cA + kstep, voffA); PG8_STAGE(PG8_SB(1, 1), cB + hstep + kstep, voffB);
        PG8_WAIT_V(6); PG8_BAR;
    } else {
        PG8_STAGE(PG8_SB(0, 0), cB, voffB); PG8_STAGE(PG8_SA(0, 0), cA, voffA); PG8_STAGE(PG8_SB(0, 1), cB + hstep, voffB); PG8_STAGE(PG8_SA(0, 1), cA + hstep, voffA);
        if (wr == 1) PG8_BAR;
        PG8_WAIT_V(4); PG8_BAR;
        PG8_STAGE(PG8_SB(1, 0), cB + kstep, voffB); PG8_STAGE(PG8_SA(1, 0), cA + kstep, voffA); PG8_STAGE(PG8_SB(1, 1), cB + hstep + kstep, voffB);
        PG8_WAIT_V(6); PG8_BAR;
    }
    for (;;) {
        const bool has_next = S.next(ui + 1, nxt);
        const char* nA = has_next ? (const char*)g.A + (size_t)nxt.pm * tstep : cA; const char* nB = has_next ? (const char*)g.Bt + (size_t)nxt.pn * tstep : cB;
        for (int t = 0; t < nt; t += 2) {
            const bool last = (t == nt - 2);
            if constexpr (Epi::KHOOK) { if (t == Epi::KT1 || t == Epi::KT2) E.khook(acc, cur, t, wr, wc, fr, fq); }
            const char* a1 = cA + (size_t)(t + 1) * kstep;
            const char* a2 = last ? nA : cA + (size_t)(t + 2) * kstep; const char* b2 = last ? nB : cB + (size_t)(t + 2) * kstep;
            const char* a3 = a2 + kstep; const char* b3 = b2 + kstep;
            if (last && has_next) S.a_ready(nxt);
            if constexpr (SP2) {
            PG8_LDB(B0, 0, 0); PG8_LDB(B1, 0, 1); PG8_SCHED; PG8_LDA(At, 0, 0); PG8_STAGE(PG8_SA(1, 1), a1 + hstep, voffA);
            PG8_WAIT_V(8); PG8_WAIT_L(0); PG8_BAR; PG8_MMA(0, 0, At, B0); PG8_MMA(0, 1, At, B1); PG8_BAR; PG8_SCHED;
            PG8_LDA(At, 0, 1); PG8_STAGE(PG8_SB(0, 0), b2, voffB); PG8_STAGE(PG8_SB(0, 1), b2 + hstep, voffB); PG8_STAGE(PG8_SA(0, 0), a2, voffA);
            PG8_WAIT_V(8); PG8_WAIT_L(0); PG8_BAR; PG8_MMA(1, 0, At, B0); PG8_MMA(1, 1, At, B1); PG8_BAR; PG8_SCHED;
            PG8_LDB(B0, 1, 0); PG8_LDB(B1, 1, 1); PG8_SCHED; PG8_LDA(At, 1, 0); PG8_STAGE(PG8_SA(0, 1), a2 + hstep, voffA);
            PG8_WAIT_V(8); PG8_WAIT_L(0); PG8_BAR; PG8_MMA(0, 0, At, B0); PG8_MMA(0, 1, At, B1); PG8_BAR; PG8_SCHED;
            PG8_LDA(At, 1, 1); PG8_STAGE(PG8_SB(1, 0), b3, voffB); PG8_STAGE(PG8_SB(1, 1), b3 + hstep, voffB); PG8_STAGE(PG8_SA(1, 0), a3, voffA);
            PG8_WAIT_V(8); PG8_WAIT_L(0); PG8_BAR; PG8_MMA(1, 0, At, B0); PG8_MMA(1, 1, At, B1); PG8_BAR; PG8_SCHED;
            } else {
            PG8_LDB(B0, 0, 0); PG8_SCHED; PG8_LDA(At, 0, 0); PG8_STAGE(PG8_SA(1, 1), a1 + hstep, voffA);
            PG8_WAIT_L(8); PG8_BAR; PG8_WAIT_L(0); PG8_MMA(0, 0, At, B0); PG8_BAR; PG8_SCHED;
            PG8_LDB(B1, 0, 1); PG8_STAGE(PG8_SB(0, 0), b2, voffB);
            PG8_BAR; PG8_WAIT_L(0); PG8_MMA(0, 1, At, B1); PG8_BAR;
            PG8_LDA(At, 0, 1); PG8_STAGE(PG8_SA(0, 0), a2, voffA);
            PG8_BAR; PG8_WAIT_L(0); PG8_MMA(1, 0, At, B0); PG8_BAR; PG8_SCHED;
            PG8_STAGE(PG8_SB(0, 1), b2 + hstep, voffB);
            PG8_WAIT_V(6); PG8_BAR; PG8_MMA(1, 1, At, B1); PG8_BAR;
            PG8_LDB(B0, 1, 0); PG8_SCHED; PG8_LDA(At, 1, 0); PG8_STAGE(PG8_SA(0, 1), a2 + hstep, voffA);
            PG8_WAIT_L(8); PG8_BAR; PG8_WAIT_L(0); PG8_MMA(0, 0, At, B0); PG8_BAR; PG8_SCHED;
            PG8_LDB(B1, 1, 1); PG8_STAGE(PG8_SB(1, 0), b3, voffB);
            PG8_BAR; PG8_WAIT_L(0); PG8_MMA(0, 1, At, B1); PG8_BAR;
            PG8_LDA(At, 1, 1); PG8_STAGE(PG8_SA(1, 0), a3, voffA);
            PG8_BAR; PG8_WAIT_L(0); PG8_MMA(1, 0, At, B0); PG8_BAR; PG8_SCHED;
            PG8_STAGE(PG8_SB(1, 1), b3 + hstep, voffB);
            PG8_WAIT_V(6); PG8_BAR; PG8_MMA(1, 1, At, B1); PG8_BAR;
            }
        }
        if constexpr (ALIGN_EPI) { if (wr == 0) PG8_BAR; }
        if constexpr (!Epi::AFTER_DRAIN) { E(acc, cur, wr, wc, fr, fq, auxb + (ui & 1) * 4096); S.done(cur); }
        if (!has_next) break;
#pragma unroll
        for (int a = 0; a < 2; ++a)
#pragma unroll
            for (int b = 0; b < 2; ++b)
#pragma unroll
                for (int m = 0; m < 4; ++m)
#pragma unroll
                    for (int n = 0; n < 2; ++n) acc[a][b][m][n] = (f32x4){0.f, 0.f, 0.f, 0.f};
        cur = nxt; cA = nA; cB = nB; ++ui;
        if constexpr (Epi::PREP) E.prep(auxb + (ui & 1) * 4096, cur, wid, lane);
        if constexpr (ALIGN_EPI) { if (wr == 1) PG8_BAR; }
    }
    PG8_WAIT_V(0);
    if constexpr (!ALIGN_EPI) { if (wr == 0) PG8_BAR; }
    PG8_BAR;
    if constexpr (Epi::AFTER_DRAIN) { E.fused(acc, cur, wr, wc, fr, fq, lds, wid, lane); S.done(cur); }
#undef PG8_SA
#undef PG8_SB
#undef PG8_STAGE
#undef PG8_LDA
#undef PG8_LDB
#undef PG8_MMA
#undef PG8_WAIT_V
#undef PG8_WAIT_L
#undef PG8_BAR
#undef PG8_SCHED
}
}
#define GAS __attribute__((address_space(1)))
#define LAS __attribute__((address_space(3)))
typedef unsigned short bf16;
typedef unsigned v4u __attribute__((ext_vector_type(4)));
typedef float f32x4 __attribute__((ext_vector_type(4)));
typedef short bf16x8 __attribute__((ext_vector_type(8)));
typedef GAS unsigned gu32;
typedef GAS unsigned long long gu64;
#define RLX_AGENT __ATOMIC_RELAXED, __HIP_MEMORY_SCOPE_AGENT
#define LDS_WAIT() asm volatile("s_waitcnt lgkmcnt(0)" ::: "memory")
#define VM_WAIT() asm volatile("s_waitcnt vmcnt(0)" ::: "memory")
__device__ __forceinline__ unsigned long long rt() { return __builtin_amdgcn_s_memrealtime(); }
__device__ __forceinline__ unsigned f2bf(float f) { unsigned u = __builtin_bit_cast(unsigned, f); return (u + 0x7fffu + ((u >> 16) & 1u)) >> 16; }
__device__ __forceinline__ unsigned pk2(float lo, float hi) { return f2bf(lo) | (f2bf(hi) << 16); }

#define XB_TMO      128
#define XB_XCNT(j)  (256  + 64 * (j))
#define XB_XSUB(j)  (1280 + 64 * (j))
#define XB_XGEN(j)  (2304 + 64 * (j))
#define XB_TOP      3328
#define XB_TOPGEN   3392
#define XCD_BAR_WORDS 3456
#define XB_SPIN_CAP (1u << 26)

__device__ __forceinline__ unsigned xb_ld(unsigned* p)              { return __hip_atomic_load(p, __ATOMIC_RELAXED, __HIP_MEMORY_SCOPE_AGENT); }
__device__ __forceinline__ unsigned xb_add(unsigned* p, unsigned v) { return __hip_atomic_fetch_add(p, v, __ATOMIC_RELAXED, __HIP_MEMORY_SCOPE_AGENT); }
__device__ __forceinline__ unsigned xb_xcc_id() { return (unsigned)__builtin_amdgcn_s_getreg((3 << 11) | 20) & 0xFu; }
#define XB_SPIN(cond, bar) do { unsigned _sp = 0; while (cond) { __builtin_amdgcn_s_sleep(1); \
    if ((++_sp & 255u) == 0u) { if (xb_ld(&(bar)[XB_TMO])) break; if (_sp > XB_SPIN_CAP) { atomicAdd(&(bar)[XB_TMO], 1u); break; } } } } while (0)

struct XcdBarrier {
    unsigned* bar; unsigned x;
    volatile LAS unsigned* st;
};

__device__ __forceinline__ XcdBarrier xcd_barrier_post(unsigned* bar, volatile LAS unsigned* st) {
    XcdBarrier b; b.bar = bar; b.x = xb_xcc_id(); b.st = st;
    if (threadIdx.x == 0) (void)xb_add(&bar[XB_XCNT(b.x)], 1u);
    return b;
}
__device__ __forceinline__ void xcd_barrier_complete(unsigned* bar, unsigned x, unsigned& nloc, unsigned& nx) {
    const unsigned G = gridDim.x * gridDim.y * gridDim.z;
    unsigned sum, cnt, mine, sp = 0u;
    for (;;) {
        sum = 0u; cnt = 0u; mine = 0u;
#pragma unroll
        for (unsigned j = 0; j < 16; ++j) { const unsigned c = xb_ld(&bar[XB_XCNT(j)]); sum += c; cnt += (c > 0u) ? 1u : 0u; mine = (j == x) ? c : mine; }
        if (sum == G) break;
        __builtin_amdgcn_s_sleep(1);
        if ((++sp & 255u) == 0u) { if (xb_ld(&bar[XB_TMO])) break; if (sp > XB_SPIN_CAP) { atomicAdd(&bar[XB_TMO], 1u); break; } }
    }
    nloc = mine > 0u ? mine : 1u; nx = cnt > 0u ? cnt : 1u;
}

__device__ __forceinline__ void xcd_barrier(const XcdBarrier& b) {
    asm volatile("s_waitcnt vmcnt(0)" ::: "memory");
    __syncthreads();
    if (threadIdx.x == 0) {
        unsigned* bar = b.bar;
        __builtin_amdgcn_s_waitcnt(0);
        unsigned nloc = b.st[0], nx = b.st[1];
        if (nloc == 0u) { xcd_barrier_complete(bar, b.x, nloc, nx); b.st[0] = nloc; b.st[1] = nx; }
        const unsigned old = xb_add(&bar[XB_XSUB(b.x)], 1u);
        const unsigned gen = old / nloc;
        if (old + 1u == (gen + 1u) * nloc) {
            __builtin_amdgcn_fence(__ATOMIC_RELEASE, "agent");
            asm volatile("s_waitcnt vmcnt(0)" ::: "memory");
            asm volatile("buffer_inv sc1" ::: "memory");
            const unsigned og = xb_add(&bar[XB_TOP], 1u);
            const unsigned tg = og / nx;
            if (og + 1u == (tg + 1u) * nx) xb_add(&bar[XB_TOPGEN], 1u);
            else XB_SPIN(xb_ld(&bar[XB_TOPGEN]) == tg, bar);
            asm volatile("s_waitcnt vmcnt(0)" ::: "memory");
        } else {
            asm volatile("buffer_inv sc1" ::: "memory");
            XB_SPIN(xb_ld(&bar[XB_TOPGEN]) == gen, bar);
            asm volatile("s_waitcnt vmcnt(0)" ::: "memory");
        }
    }
    __syncthreads();
}

constexpr int NWAVES = 8;
constexpr int D = 1024, NBATCH = 4, SEQ = 4096, MP = NBATCH * SEQ, MS = 32, MROWS = MP + MS, MPAD = 16640;
constexpr int DFF = 2816, INCOLS = 6400, KCAT = 1280;
static_assert(MP == pg8::P_MP && MROWS == pg8::P_MROWS && DFF == pg8::P_DFF, "constants");
constexpr size_t O_W0P = (size_t)MROWS * D, O_W1P = O_W0P + 262144, O_W2P = O_W1P + 1048576, O_PP = O_W2P + 4194304, O_MKV = O_PP + 30720,
                 O_W0S = O_MKV + 1048576, O_W1S = O_W0S + 16384, O_W2S = O_W1S + 16384, O_PS = O_W2S + 16384, O_END = O_PS + 16384;
constexpr size_t MiB = 1u << 20;
constexpr size_t WS_CTL = 0, CTL_ZERO_BYTES = MiB;
constexpr size_t WS_SSQ0 = 1 * MiB, WS_SSQ1 = WS_SSQ0 + 512 * 1024, WS_SSQ2 = 2 * MiB, WS_SSQ3 = WS_SSQ2 + 512 * 1024, WS_SSQM = 3 * MiB, WS_BIAS = WS_SSQM + 256 * 1024, WS_BIAS2 = WS_BIAS + 8192;
constexpr size_t WS_W1GU = 4 * MiB, WS_W1D = 15 * MiB, WS_WIN = WS_W1D + 5632 * 1024, WS_WMEM = 33 * MiB, WS_WOA = 35 * MiB, WS_WOB = WS_WOA + 512 * 1024, WS_WOC = WS_WOB + MiB,
                 WS_WOUT = WS_WOC + MiB, WS_W2GU = WS_WOUT + 2 * MiB, WS_W2D = WS_W2GU + 11 * MiB, WS_WPOOL = 56 * MiB;
constexpr size_t WS_AMEM = 57 * MiB, WS_MEMKV = 59 * MiB, WS_XB = 61 * MiB, WS_H = 94 * MiB, WS_QKV = WS_H, WS_QM = 298 * MiB + 512 * 1024;
constexpr size_t WS_G = 184 * MiB, WS_Z = 282 * MiB, WS_MB = 315 * MiB, WS_O3 = 315 * MiB, WS_LSE = 364 * MiB, WS_ABC = 365 * MiB, WS_END = 408 * MiB;
static_assert(WS_W1GU + 5632ull * 1024 * 2 <= WS_W1D && WS_W1D + 1024ull * 2816 * 2 <= WS_WIN && WS_WIN + 6400ull * 1024 * 2 <= WS_WMEM && WS_W2D + 1024ull * 2816 * 2 <= WS_WPOOL, "weight map");
static_assert(WS_XB + (size_t)MPAD * 1024 * 2 <= WS_H && WS_H + (size_t)MPAD * 2816 * 2 <= WS_G && WS_QKV + (size_t)MPAD * 2304 * 2 <= WS_H + (size_t)MP * 2816 * 2, "map 1");
static_assert(WS_G + (size_t)MPAD * 3072 * 2 <= WS_Z && WS_Z + (size_t)MPAD * 512 * 2 <= WS_QM && WS_QM + (size_t)MPAD * 512 * 2 <= WS_O3 && WS_MB + (size_t)MPAD * 1024 * 2 <= WS_LSE && WS_O3 + 3ull * MPAD * 256 * 4 <= WS_LSE, "map 2");
static_assert(WS_ABC + (size_t)MPAD * 1280 * 2 <= WS_END && WS_WOA + 1024ull * 1280 * 2 <= WS_WOUT, "map 3");
constexpr int CW_BAR = 4096, CW_FIN = 16384, CW_FINS = CW_FIN + 64 * 64, CW_SMP = 40960;
constexpr int RING_BYTES = 131072, LDSCTL_OFF = RING_BYTES, MISC_OFF = LDSCTL_OFF + 320, LDS_BYTES = 147456;

struct Args { const float* in[28]; float* out; unsigned char* ws; };

__device__ __forceinline__ float wave_sum(float v) {
#pragma unroll
    for (int o = 1; o < 64; o <<= 1) v += __shfl_xor(v, o);
    return v;
}
__device__ __forceinline__ float wave_max(float v) {
#pragma unroll
    for (int o = 1; o < 64; o <<= 1) v = fmaxf(v, __shfl_xor(v, o));
    return v;
}
__device__ __forceinline__ float bf2f(bf16 v) { return __uint_as_float((unsigned)v << 16); }
__device__ __forceinline__ float blo(unsigned w) { return __uint_as_float(w << 16); }
__device__ __forceinline__ float bhi(unsigned w) { return __uint_as_float(w & 0xffff0000u); }

__device__ __forceinline__ void p0_transpose_item(const float* W, int N, const float* gs, bf16* WT, int Kd, int k0, int n0, int drow0, LAS float* scr, int lane) {
    float wv[32];
#pragma unroll
    for (int i = 0; i < 32; ++i) wv[i] = __builtin_nontemporal_load(W + (size_t)(k0 + 2 * i + (lane >> 5)) * N + n0 + (lane & 31));
    if (gs) {
#pragma unroll
        for (int i = 0; i < 32; ++i) wv[i] *= gs[k0 + 2 * i + (lane >> 5)]; }
#pragma unroll
    for (int i = 0; i < 32; ++i) scr[(2 * i + (lane >> 5)) * 33 + (lane & 31)] = wv[i];
    LDS_WAIT(); asm volatile("" ::: "memory");
    const int c = lane & 7;
#pragma unroll
    for (int j = 0; j < 4; ++j) { const int n = (lane >> 3) + 8 * j; const LAS float* s = scr + (8 * c) * 33 + n;
        v4u o; o.x = pk2(s[0 * 33], s[1 * 33]); o.y = pk2(s[2 * 33], s[3 * 33]); o.z = pk2(s[4 * 33], s[5 * 33]); o.w = pk2(s[6 * 33], s[7 * 33]);
        *(GAS v4u*)(WT + (size_t)(drow0 + n) * Kd + k0 + 8 * c) = o; }
    LDS_WAIT(); asm volatile("" ::: "memory");
}
__device__ __forceinline__ void p0_matrix_item(const float* W, int K, int N, const float* gs, bf16* WT, int mode, int r, LAS float* scr, int lane) {
    const int nblk = N / 32, kb = r / nblk, nb = r % nblk, n0 = 32 * nb;
    const int drow0 = (mode == 0) ? n0 : ((n0 >> 7) * 256 + (n0 & 127) + (mode == 2 ? 128 : 0));
    p0_transpose_item(W, N, gs, WT, K, 64 * kb, n0, drow0, scr, lane);
}
__device__ __forceinline__ void p0_matrix_item_cat(const float* W, int K, int N, bf16* WT, int Kd, int kofs, int r, LAS float* scr, int lane) {
    const int nblk = N / 32, kb = r / nblk, nb = r % nblk;
    p0_transpose_item(W, N, nullptr, WT + kofs, Kd, 64 * kb, 32 * nb, 32 * nb, scr, lane);
}
__device__ __forceinline__ void p0_row2(const float* xa, bf16* oa, float* sa, const float* xb, bf16* ob, float* sb, int lane) {
    const GAS f32x4* ra = (const GAS f32x4*)xa + lane; const GAS f32x4* rb = (const GAS f32x4*)xb + lane;
    f32x4 va[4], vb[4]; float s0 = 0.f, s1 = 0.f;
#pragma unroll
    for (int j = 0; j < 4; ++j) { va[j] = __builtin_nontemporal_load(ra + 64 * j); vb[j] = __builtin_nontemporal_load(rb + 64 * j); }
#pragma unroll
    for (int j = 0; j < 4; ++j) { s0 += (va[j].x * va[j].x + va[j].y * va[j].y) + (va[j].z * va[j].z + va[j].w * va[j].w); s1 += (vb[j].x * vb[j].x + vb[j].y * vb[j].y) + (vb[j].z * vb[j].z + vb[j].w * vb[j].w); }
    s0 = wave_sum(s0); s1 = wave_sum(s1);
    GAS unsigned long long* pa = (GAS unsigned long long*)oa + lane; GAS unsigned long long* pb = (GAS unsigned long long*)ob + lane;
#pragma unroll
    for (int j = 0; j < 4; ++j) { pa[64 * j] = (unsigned long long)pk2(va[j].x, va[j].y) | ((unsigned long long)pk2(va[j].z, va[j].w) << 32);
        pb[64 * j] = (unsigned long long)pk2(vb[j].x, vb[j].y) | ((unsigned long long)pk2(vb[j].z, vb[j].w) << 32); }
    if (lane == 0) { *(f32x4*)sa = (f32x4){s0, 0.f, 0.f, 0.f}; *(f32x4*)sb = (f32x4){s1, 0.f, 0.f, 0.f}; }
}
__device__ __forceinline__ void p0_row(const float* xrow, bf16* orow, float* ssq, int lane) {
    const GAS f32x4* xr = (const GAS f32x4*)xrow + lane;
    f32x4 v[4]; float s = 0.f;
#pragma unroll
    for (int j = 0; j < 4; ++j) { v[j] = xr[64 * j]; s += (v[j].x * v[j].x + v[j].y * v[j].y) + (v[j].z * v[j].z + v[j].w * v[j].w); }
    s = wave_sum(s);
    GAS unsigned long long* o8 = (GAS unsigned long long*)orow + lane;
#pragma unroll
    for (int j = 0; j < 4; ++j) o8[64 * j] = (unsigned long long)pk2(v[j].x, v[j].y) | ((unsigned long long)pk2(v[j].z, v[j].w) << 32);
    if (lane == 0) *(f32x4*)ssq = (f32x4){s, 0.f, 0.f, 0.f};
}

typedef float f32x16 __attribute__((ext_vector_type(16)));
template <int K>
__device__ __forceinline__ void mini_gemm32(LAS unsigned char* lds, const bf16* A, const bf16* Bt, int col0, int wave, int lane, int lda = K, int ldb = K) {
    constexpr int KS = K / 8, NS = KS / 16, NB = (NS > 6) ? 6 : NS;
    const int k0 = wave * KS;
    const bf16* ap = A + (size_t)(lane & 31) * lda + k0 + 8 * (lane >> 5);
    const bf16* bp = Bt + (size_t)(col0 + (lane & 31)) * ldb + k0 + 8 * (lane >> 5);
    f32x16 acc = {0.f, 0.f, 0.f, 0.f, 0.f, 0.f, 0.f, 0.f, 0.f, 0.f, 0.f, 0.f, 0.f, 0.f, 0.f, 0.f};
#pragma unroll
    for (int s0 = 0; s0 < NS; s0 += NB) { bf16x8 av[NB], bv[NB];
#pragma unroll
        for (int j = 0; j < NB; ++j) if (s0 + j < NS) { av[j] = *(const bf16x8*)(ap + 16 * (s0 + j)); bv[j] = *(const bf16x8*)(bp + 16 * (s0 + j)); }
#pragma unroll
        for (int j = 0; j < NB; ++j) if (s0 + j < NS) acc = __builtin_amdgcn_mfma_f32_32x32x16_bf16(av[j], bv[j], acc, 0, 0, 0); }
    LAS float* part = (LAS float*)lds;
#pragma unroll
    for (int r = 0; r < 16; ++r) part[(wave * 16 + r) * 64 + lane] = acc[r];
    __syncthreads();
}
__device__ __forceinline__ float mini_elem(LAS unsigned char* lds, int tid, int i, int& row, int& col) {
    const int r = (tid >> 6) + 8 * i, l = tid & 63; const LAS float* part = (const LAS float*)lds; float v = 0.f;
#pragma unroll
    for (int w = 0; w < 8; ++w) v += part[(w * 16 + r) * 64 + l];
    row = (r & 3) + 8 * (r >> 2) + 4 * (l >> 5); col = l & 31; return v;
}
__device__ __forceinline__ float half_sum32(float s) { s += __shfl_xor(s, 1); s += __shfl_xor(s, 2); s += __shfl_xor(s, 4); s += __shfl_xor(s, 8); s += __shfl_xor(s, 16); return s; }
template <int K>
__device__ __forceinline__ void sample_resid(LAS unsigned char* lds, const bf16* A, const bf16* Bt, const float* basef, bf16* xb, float* ssq_out, float scale, int ct, int tid, int wave, int lane) {
    mini_gemm32<K>(lds, A, Bt, 32 * ct, wave, lane);
#pragma unroll
    for (int i = 0; i < 2; ++i) { int row, col; const float v = mini_elem(lds, tid, i, row, col); const size_t off = (size_t)row * 1024 + 32 * ct + col;
        const float xn = (basef ? basef[off] : bf2f(xb[off])) + scale * v; xb[off] = (bf16)f2bf(xn);
        const float s = half_sum32(xn * xn); if ((lane & 31) == 0) atomicAdd(ssq_out + row * 4 + (ct & 3), s); }
    __syncthreads();
}
template <int K>
__device__ __forceinline__ void sample_final(LAS unsigned char* lds, const bf16* A, const bf16* Bt, const bf16* base, float* out, const float* gfin, float* ssq, unsigned* cnt, float scale, int ct, int tid, int wave, int lane) {
    mini_gemm32<K>(lds, A, Bt, 32 * ct, wave, lane);
    float xn[2]; int rr[2], cc[2];
#pragma unroll
    for (int i = 0; i < 2; ++i) { const float v = mini_elem(lds, tid, i, rr[i], cc[i]); xn[i] = bf2f(base[(size_t)rr[i] * 1024 + 32 * ct + cc[i]]) + scale * v;
        const float s = half_sum32(xn[i] * xn[i]); if ((lane & 31) == 0) atomicAdd(ssq + rr[i] * 4 + (ct & 3), s); }
    asm volatile("s_waitcnt vmcnt(0)" ::: "memory");
    __syncthreads();
    if (tid == 0) { __hip_atomic_fetch_add(cnt, 1u, __ATOMIC_RELAXED, __HIP_MEMORY_SCOPE_AGENT);
        unsigned sp = 0; while (__hip_atomic_load(cnt, __ATOMIC_RELAXED, __HIP_MEMORY_SCOPE_AGENT) < 32u) { __builtin_amdgcn_s_sleep(1); if (++sp > (1u << 24)) break; } }
    __syncthreads();
#pragma unroll
    for (int i = 0; i < 2; ++i) { const float* sp4 = ssq + rr[i] * 4;
        const float a = __hip_atomic_load(sp4, __ATOMIC_RELAXED, __HIP_MEMORY_SCOPE_AGENT), b = __hip_atomic_load(sp4 + 1, __ATOMIC_RELAXED, __HIP_MEMORY_SCOPE_AGENT),
                    c = __hip_atomic_load(sp4 + 2, __ATOMIC_RELAXED, __HIP_MEMORY_SCOPE_AGENT), d = __hip_atomic_load(sp4 + 3, __ATOMIC_RELAXED, __HIP_MEMORY_SCOPE_AGENT);
        const float ri = rsqrtf(((a + b) + (c + d)) * (1.0f / 1024.0f) + 1e-6f);
        out[(size_t)rr[i] * 1024 + 32 * ct + cc[i]] = xn[i] * ri * gfin[32 * ct + cc[i]]; }
    __syncthreads();
}

__device__ __forceinline__ void wg_publish(unsigned* cnt, int tid) {
    asm volatile("s_waitcnt vmcnt(0)" ::: "memory"); __syncthreads();
    if (tid == 0) { __builtin_amdgcn_fence(__ATOMIC_RELEASE, "agent"); asm volatile("s_waitcnt vmcnt(0)" ::: "memory"); __hip_atomic_fetch_add(cnt, 1u, __ATOMIC_RELAXED, __HIP_MEMORY_SCOPE_AGENT); }
}
__device__ __forceinline__ void wg_wait(unsigned* cnt, unsigned need, int tid) {
    if (tid == 0) { unsigned sp = 0; while (__hip_atomic_load(cnt, __ATOMIC_RELAXED, __HIP_MEMORY_SCOPE_AGENT) < need) { __builtin_amdgcn_s_sleep(2); if (++sp > (1u << 24)) break; }
        __builtin_amdgcn_fence(__ATOMIC_ACQUIRE, "agent"); asm volatile("s_waitcnt vmcnt(0)" ::: "memory"); }
    __syncthreads();
}

typedef short s16x4 __attribute__((ext_vector_type(4)));
#define KO(r) (((r) & 3) + 8 * ((r) >> 2))
constexpr float LOG2E = 1.4426950408889634f;
constexpr float MASKV = -1e30f, MINIT = -5e29f;
constexpr int TAB_N = 384;
__device__ __forceinline__ s16x4 vtr(const LAS unsigned char* p) { return __builtin_bit_cast(s16x4, __builtin_amdgcn_ds_read_tr16_b64_v4i16((LAS s16x4*)p)); }

template <int DH>
__device__ __forceinline__ void attn_finish(f32x16 (&o)[DH / 32], float l, bf16* dst, size_t qstride, LAS float* xch, int lane) {
    constexpr int DB = DH / 32; const int h = lane >> 5;
    l += __shfl_xor(l, 32);
    if (h == 0) xch[lane] = 1.0f / l;
    LDS_WAIT(); asm volatile("" ::: "memory");
#pragma unroll
    for (int r = 0; r < 16; ++r) { const float il = xch[KO(r) + 4 * h]; bf16* dq = dst + qstride * (size_t)(KO(r) + 4 * h) + (lane & 31);
#pragma unroll
        for (int db = 0; db < DB; ++db) dq[32 * db] = (bf16)f2bf(o[db][r] * il); }
    asm volatile("" ::: "memory");
}
template <int DH, bool TAB>
__device__ __forceinline__ void softmax_pv(const f32x16 s, f32x16 (&o)[DH / 32], float& m, float& l, const LAS unsigned char* vt, const LAS float* tb, int kmin, LAS float* xch, int lane) {
    constexpr int DB = DH / 32, VP = DH * 2 + 64; const int h = lane >> 5;
    float x[16];
#pragma unroll
    for (int r = 0; r < 16; ++r) x[r] = TAB ? __builtin_fmaf(s[r], LOG2E, tb[KO(r)]) : s[r] * LOG2E;
    if (kmin > 0) {
#pragma unroll
        for (int r = 0; r < 16; ++r) if (KO(r) + 4 * h < kmin) x[r] = MASKV;
    }
    float bm = fmaxf(fmaxf(x[0], x[1]), fmaxf(x[2], x[3]));
#pragma unroll
    for (int r = 4; r < 16; r += 4) bm = fmaxf(bm, fmaxf(fmaxf(x[r], x[r + 1]), fmaxf(x[r + 2], x[r + 3])));
    bm = fmaxf(bm, __shfl_xor(bm, 32));
    const float mn = fmaxf(m, bm);
    if (__any(bm > m + 8.0f)) {
        const float a = __builtin_amdgcn_exp2f(m - mn); l *= a; m = mn;
        if (h == 0) xch[lane] = a;
        LDS_WAIT(); asm volatile("" ::: "memory");
#pragma unroll
        for (int r = 0; r < 16; ++r) { const float ar = xch[KO(r) + 4 * h];
#pragma unroll
            for (int db = 0; db < DB; ++db) o[db][r] *= ar; }
        asm volatile("" ::: "memory");
    }
    float ps = 0.f;
#pragma unroll
    for (int r = 0; r < 16; ++r) { x[r] = __builtin_amdgcn_exp2f(x[r] - m); ps += x[r]; }
    l += ps;
    v4u pw0, pw1;
    pw0.x = pg8::cvt_pk_bf16(x[0], x[1]); pw0.y = pg8::cvt_pk_bf16(x[2], x[3]); pw0.z = pg8::cvt_pk_bf16(x[4], x[5]); pw0.w = pg8::cvt_pk_bf16(x[6], x[7]);
    pw1.x = pg8::cvt_pk_bf16(x[8], x[9]); pw1.y = pg8::cvt_pk_bf16(x[10], x[11]); pw1.z = pg8::cvt_pk_bf16(x[12], x[13]); pw1.w = pg8::cvt_pk_bf16(x[14], x[15]);
    const bf16x8 pa0 = __builtin_bit_cast(bf16x8, pw0), pa1 = __builtin_bit_cast(bf16x8, pw1);
    const LAS unsigned char* vb = vt + (((lane & 15) >> 2) + 4 * h) * VP + (16 * ((lane >> 4) & 1) + 4 * (lane & 3)) * 2;
#pragma unroll
    for (int db = 0; db < DB; ++db) {
        const s16x4 l0 = vtr(vb + db * 64), h0 = vtr(vb + db * 64 + 8 * VP), l1 = vtr(vb + db * 64 + 16 * VP), h1 = vtr(vb + db * 64 + 24 * VP);
        const bf16x8 b0 = {l0[0], l0[1], l0[2], l0[3], h0[0], h0[1], h0[2], h0[3]}, b1 = {l1[0], l1[1], l1[2], l1[3], h1[0], h1[1], h1[2], h1[3]};
        o[db] = __builtin_amdgcn_mfma_f32_32x32x16_bf16(pa0, b0, o[db], 0, 0, 0);
        o[db] = __builtin_amdgcn_mfma_f32_32x32x16_bf16(pa1, b1, o[db], 0, 0, 0);
    }
}
struct KVBuf { v4u kr[4]; v4u vr[4]; };
__device__ __forceinline__ void attn_load64(KVBuf& B, const bf16* vp, long vstep, int imin) {
#pragma unroll
    for (int i = 0; i < 4; ++i) { const bf16* p = vp + (long)(i < imin ? imin : i) * vstep; B.kr[i] = *(const v4u*)(p - 768); B.vr[i] = *(const v4u*)p; }
}
__device__ __forceinline__ void attn_compute64(const KVBuf& B, const bf16x8 (&qf)[4], f32x16 (&o)[2], float& m, float& l, LAS unsigned char* kl  , const LAS float* tb, int kmin, LAS float* xch, int lane) {
    const int q = lane & 31, h = lane >> 5; LAS unsigned char* vl = kl + 4608;
#pragma unroll
    for (int i = 0; i < 4; ++i) { *(LAS v4u*)(kl + ((lane >> 3) + 8 * i) * 144 + (lane & 7) * 16) = B.kr[i]; *(LAS v4u*)(vl + ((lane >> 3) + 8 * i) * 192 + (lane & 7) * 16) = B.vr[i]; }
    f32x16 s = {0.f, 0.f, 0.f, 0.f, 0.f, 0.f, 0.f, 0.f, 0.f, 0.f, 0.f, 0.f, 0.f, 0.f, 0.f, 0.f};
#pragma unroll
    for (int ks = 0; ks < 4; ++ks) { const bf16x8 kf = *(const LAS bf16x8*)(kl + q * 144 + (16 * ks + 8 * h) * 2); s = __builtin_amdgcn_mfma_f32_32x32x16_bf16(kf, qf[ks], s, 0, 0, 0); }
    softmax_pv<64, true>(s, o, m, l, vl, tb, kmin, xch, lane);
}
__device__ __forceinline__ void attn_job(const bf16* QKV, bf16* AO, int b, int hh, int n, int c, LAS unsigned char* vl, const LAS float* tabL, LAS float* xch, int lane) {
    const long rowb = (long)b * 4096; const int T0 = 128 * n;
    const int kb0 = (n == 0) ? 4 : 0, c0 = 8 - kb0, kb1 = (n < 4) ? 4 - n : 0, c1 = 5 - kb1;
    int kb2 = 0; while (8 * n - 128 + 32 * kb2 + 31 < 0) ++kb2;
    f32x16 o[2]; float m = MINIT, l = 0.f;
#pragma unroll
    for (int r = 0; r < 16; ++r) { o[0][r] = 0.f; o[1][r] = 0.f; }
    bf16x8 qf[4];
    for (int st = 0; st < 6; ++st) {
        const int g = (st < 2) ? st : 2, rc = st - 2;
        const int kbf = (g == 0) ? kb0 : (g == 1) ? kb1 : kb2, cnt = (g == 0) ? c0 : (g == 1) ? c1 : 5 - kb2;
        int ln = lane; asm volatile("" : "+v"(ln)); const int q = ln & 31, h = ln >> 5;
        if (st <= 2) { const bf16* qr = QKV + (rowb + T0 + c + 4 * q) * 2304 + hh * 64 + 8 * h + 256 * g;
#pragma unroll
            for (int ks = 0; ks < 4; ++ks) qf[ks] = *(const bf16x8*)(qr + 16 * ks); }
        asm volatile("" ::: "memory");
        long row; long vstep; const LAS float* tb; int kmin = 0;
        if (g == 0) { row = rowb + T0 - 128 + 32 * kbf + (ln >> 3); vstep = 8 * 2304; tb = tabL + 127 + 32 * kbf + 4 * h - (c + 4 * q); }
        else if (g == 1) { row = rowb + 4 * ((long)32 * n - 128 + 32 * kbf + (ln >> 3)) + c; vstep = 32 * 2304; tb = tabL + TAB_N + 127 + 32 * kbf + 4 * h - q; }
        else { const int j0 = 8 * n - 128 + 32 * kbf; kmin = (j0 < 0) ? -j0 : 0; row = rowb + 16 * ((long)j0 + (ln >> 3)) + c + 4 * rc; vstep = 128 * 2304;
               tb = ((q & 3) == rc) ? tabL + 2 * TAB_N + 127 + 32 * kbf + 4 * h - (q >> 2) : tabL + 3 * TAB_N; }
        const bf16* vp = QKV + row * 2304 + 1536 + 256 * g + hh * 64 + (ln & 7) * 8;
        const long bstep = 4 * vstep;
        const int tstep = (g == 2 && (q & 3) != rc) ? 0 : 32;
        KVBuf A, Bb;
        attn_load64(A, vp, vstep, kmin >> 3);
        for (int i = 0; i < cnt; i += 2) {
            const bool has1 = (i + 1 < cnt), has2 = (i + 2 < cnt);
            const bf16* vp1 = has1 ? vp + bstep : vp; const bf16* vp2 = has2 ? vp + 2 * bstep : vp1;
            attn_load64(Bb, vp1, vstep, has1 ? 0 : (kmin >> 3));
            attn_compute64(A, qf, o, m, l, vl, tb, (i == 0) ? kmin : 0, xch, lane);
            attn_load64(A, vp2, vstep, (has2 || has1) ? 0 : (kmin >> 3));
            if (has1) attn_compute64(Bb, qf, o, m, l, vl, tb + tstep, 0, xch, lane);
            vp = vp2; tb += 2 * tstep;
        }
    }
    attn_finish<64>(o, l, AO + (rowb + T0 + c) * KCAT + hh * 64, (size_t)4 * KCAT, xch, lane);
}
__device__ __forceinline__ void memattn_wg(const bf16* QM, const bf16* KV, bf16* CO, int b, int hh, int qb, LAS unsigned char* Lb, LAS float* xch, int tid_, int lane_) {
    int tid = tid_; asm volatile("" : "+v"(tid)); const int lane = tid & 63;
    (void)lane_; const int q = lane & 31, h = lane >> 5;
    const size_t row0 = (size_t)b * 4096 + 32 * qb;
    const bf16* qrow = QM + (row0 + q) * 512 + hh * 128 + 8 * h;
    LAS unsigned char* Kt = Lb; LAS unsigned char* Vt = Lb + 128 * 272;
    f32x16 o[4]; float m = MINIT, l = 0.f;
#pragma unroll
    for (int r = 0; r < 16; ++r) { o[0][r] = 0.f; o[1][r] = 0.f; o[2][r] = 0.f; o[3][r] = 0.f; }
    bf16x8 qf[8];
#pragma unroll
    for (int ks = 0; ks < 8; ++ks) qf[ks] = *(const bf16x8*)(qrow + 16 * ks);
    for (int half = 0; half < 2; ++half) {
        __syncthreads();
        v4u kr[4], vr[4];
#pragma unroll
        for (int i = 0; i < 4; ++i) { const int idx = tid + 512 * i, row = idx >> 4, pc = idx & 15; const bf16* p = KV + ((size_t)b * 256 + 128 * half + row) * 1024 + hh * 128 + pc * 8; kr[i] = *(const v4u*)p; vr[i] = *(const v4u*)(p + 512); }
#pragma unroll
        for (int i = 0; i < 4; ++i) { const int idx = tid + 512 * i, row = idx >> 4, pc = idx & 15; *(LAS v4u*)(Kt + row * 272 + pc * 16) = kr[i]; *(LAS v4u*)(Vt + row * 320 + pc * 16) = vr[i]; }
        __syncthreads();
        for (int kb = 0; kb < 4; ++kb) {
            f32x16 s = {0.f, 0.f, 0.f, 0.f, 0.f, 0.f, 0.f, 0.f, 0.f, 0.f, 0.f, 0.f, 0.f, 0.f, 0.f, 0.f};
#pragma unroll
            for (int ks = 0; ks < 8; ++ks) { const bf16x8 kf = *(const LAS bf16x8*)(Kt + (32 * kb + q) * 272 + (16 * ks + 8 * h) * 2); s = __builtin_amdgcn_mfma_f32_32x32x16_bf16(kf, qf[ks], s, 0, 0, 0); }
            softmax_pv<128, false>(s, o, m, l, Vt + (32 * kb) * 320, nullptr, 0, xch, lane);
        }
    }
    attn_finish<128>(o, l, CO + row0 * KCAT + hh * 128, (size_t)KCAT, xch, lane);
}
__device__ __forceinline__ void pool_mma(const LAS unsigned char* tl, const bf16* WP, const float* pscale, bf16* BO, int m0, int gi, int lane) {
    constexpr int PITCH = 272; const int q = lane & 31, h = lane >> 5;
    f32x16 acc[4];
#pragma unroll
    for (int r = 0; r < 16; ++r) { acc[0][r] = 0.f; acc[1][r] = 0.f; acc[2][r] = 0.f; acc[3][r] = 0.f; }
    const bf16* wb = WP + (size_t)(gi * 128 + q) * 128 + 8 * h;
    bf16x8 bn[4];
#pragma unroll
    for (int db = 0; db < 4; ++db) bn[db] = *(const bf16x8*)(wb + db * 4096);
#pragma unroll
    for (int ks = 0; ks < 8; ++ks) { bf16x8 bc[4];
#pragma unroll
        for (int db = 0; db < 4; ++db) bc[db] = bn[db];
        if (ks < 7) {
#pragma unroll
            for (int db = 0; db < 4; ++db) bn[db] = *(const bf16x8*)(wb + db * 4096 + 16 * (ks + 1)); }
        const bf16x8 a = *(const LAS bf16x8*)(tl + q * PITCH + (16 * ks + 8 * h) * 2);
#pragma unroll
        for (int db = 0; db < 4; ++db) acc[db] = __builtin_amdgcn_mfma_f32_32x32x16_bf16(a, bc[db], acc[db], 0, 0, 0); }
#pragma unroll
    for (int db = 0; db < 4; ++db) { const float sc = pscale[gi * 128 + 32 * db + q];
#pragma unroll
        for (int r = 0; r < 16; ++r) BO[(size_t)(m0 + KO(r) + 4 * h) * KCAT + gi * 128 + 32 * db + q] = (bf16)f2bf(acc[db][r] * sc); }
    LDS_WAIT(); asm volatile("" ::: "memory");
}
template <int GI>
__device__ __forceinline__ void pool_job_t(const bf16* Z, const bf16* WP, const float* pscale, bf16* BO, int m0, LAS unsigned char* tl, int lane) {
    constexpr int PITCH = 272, KW = 2 << GI, NR = 31 + KW;
    const int t0s = m0 & 4095;
    unsigned zr[NR];
#pragma unroll
    for (int i = 0; i < NR; ++i) { const int tt = i - (KW - 1); zr[i] = (t0s + tt >= 0) ? *(const unsigned*)(Z + (size_t)(m0 + tt) * 512 + GI * 128 + 2 * lane) : 0u; }
    float S0 = 0.f, S1 = 0.f;
#pragma unroll
    for (int i = 0; i < KW - 1; ++i) { S0 += blo(zr[i]); S1 += bhi(zr[i]); }
#pragma unroll
    for (int tt = 0; tt < 32; ++tt) { const unsigned w = zr[tt + KW - 1]; const float z0 = blo(w), z1 = bhi(w);
        S0 += z0; S1 += z1;
        if (tt >= 1) { S0 -= blo(zr[tt - 1]); S1 -= bhi(zr[tt - 1]); }
        const int ts = t0s + tt, cnt = (ts + 1 < KW) ? ts + 1 : KW; const float inv = 1.0f / (float)cnt;
        *(LAS unsigned*)(tl + tt * PITCH + lane * 4) = pk2(S0 * inv - z0, S1 * inv - z1); }
    LDS_WAIT(); asm volatile("" ::: "memory");
    pool_mma(tl, WP, pscale, BO, m0, GI, lane);
}
__device__ __forceinline__ void pool_job(const bf16* Z, const bf16* WP, const float* pscale, bf16* BO, int m0, int gi, LAS unsigned char* tl, int lane_) {
    int lane = lane_; asm volatile("" : "+v"(lane));
    if (gi == 0) pool_job_t<0>(Z, WP, pscale, BO, m0, tl, lane); else if (gi == 1) pool_job_t<1>(Z, WP, pscale, BO, m0, tl, lane);
    else if (gi == 2) pool_job_t<2>(Z, WP, pscale, BO, m0, tl, lane); else pool_job_t<3>(Z, WP, pscale, BO, m0, tl, lane);
}
typedef unsigned v2u __attribute__((ext_vector_type(2)));
__device__ __forceinline__ f32x4 ld_bf4(const bf16* p) { const v2u w = *(const v2u*)p; return (f32x4){blo(w.x), bhi(w.x), blo(w.y), bhi(w.y)}; }
__device__ __forceinline__ float dot4(const f32x4 a, const f32x4 b) { return (a[0] * b[0] + a[1] * b[1]) + (a[2] * b[2] + a[3] * b[3]); }
__device__ __forceinline__ void sample_attn_group(const bf16* QKVrow  , const float* cache, const float* biasT, int s, int h, int g, LAS float* sx, int lane) {
    const int kq = lane >> 4, pc = lane & 15, W = 128 << (2 * g), dil = 1 << (2 * g);
    const f32x4 q4 = ld_bf4(QKVrow + g * 256 + h * 64 + 4 * pc);
    const f32x4 kn = ld_bf4(QKVrow + 768 + g * 256 + h * 64 + 4 * pc), vn = ld_bf4(QKVrow + 1536 + g * 256 + h * 64 + 4 * pc);
    float s0 = dot4(q4, kn); s0 += __shfl_xor(s0, 1); s0 += __shfl_xor(s0, 2); s0 += __shfl_xor(s0, 4); s0 += __shfl_xor(s0, 8);
    s0 += biasT[(g * 129) * 4 + h];
    const float* cb = cache + ((size_t)s * W) * 512 + h * 64 + 4 * pc;
    float sc[32];
#pragma unroll
    for (int it = 0; it < 32; ++it) { const int j = 1 + 4 * it + kq; const f32x4 kv = __builtin_nontemporal_load((const f32x4*)(cb + (size_t)(W - dil * j) * 512));
        float d = dot4(q4, kv); d += __shfl_xor(d, 1); d += __shfl_xor(d, 2); d += __shfl_xor(d, 4); d += __shfl_xor(d, 8);
        sc[it] = d + biasT[(g * 129 + j) * 4 + h]; }
    float m = s0;
#pragma unroll
    for (int it = 0; it < 32; ++it) m = fmaxf(m, sc[it]);
    m = fmaxf(m, __shfl_xor(m, 16)); m = fmaxf(m, __shfl_xor(m, 32));
    const float p0 = __expf(s0 - m); float l = 0.f; f32x4 acc = {0.f, 0.f, 0.f, 0.f};
#pragma unroll
    for (int it = 0; it < 32; ++it) { const int j = 1 + 4 * it + kq; const float p = __expf(sc[it] - m); l += p;
        const f32x4 vv = __builtin_nontemporal_load((const f32x4*)(cb + (size_t)(W - dil * j) * 512 + 256)); acc = acc + vv * p; }
    l += __shfl_xor(l, 16); l += __shfl_xor(l, 32); l += p0;
#pragma unroll
    for (int e = 0; e < 4; ++e) { float a = acc[e]; a += __shfl_xor(a, 16); a += __shfl_xor(a, 32); acc[e] = a + p0 * vn[e]; }
    const float il = 1.0f / l;
    if (kq == 0) *(LAS f32x4*)(sx + g * 72 + 4 * pc) = acc * il;
    if (lane == 0) sx[g * 72 + 64] = m + __logf(l);
}
__device__ __forceinline__ void sample_mem_quarter(const bf16* QMrow  , const float* cache, int s, int h, int qd, LAS float* sx, int lane) {
    const int kq = lane >> 5, pc = lane & 31;
    const f32x4 q4 = ld_bf4(QMrow + h * 128 + 4 * pc);
    const float* cb = cache + ((size_t)(s * 256 + 64 * qd) * 2) * 512 + h * 128 + 4 * pc;
    float sc[32];
#pragma unroll
    for (int it = 0; it < 32; ++it) { const f32x4 kv = __builtin_nontemporal_load((const f32x4*)(cb + (size_t)(2 * it + kq) * 1024));
        float d = dot4(q4, kv); d += __shfl_xor(d, 1); d += __shfl_xor(d, 2); d += __shfl_xor(d, 4); d += __shfl_xor(d, 8); d += __shfl_xor(d, 16); sc[it] = d; }
    float m = sc[0];
#pragma unroll
    for (int it = 1; it < 32; ++it) m = fmaxf(m, sc[it]);
    m = fmaxf(m, __shfl_xor(m, 32));
    float l = 0.f; f32x4 acc = {0.f, 0.f, 0.f, 0.f};
#pragma unroll
    for (int it = 0; it < 32; ++it) { const float p = __expf(sc[it] - m); l += p; const f32x4 vv = __builtin_nontemporal_load((const f32x4*)(cb + (size_t)(2 * it + kq) * 1024 + 512)); acc = acc + vv * p; }
    l += __shfl_xor(l, 32);
#pragma unroll
    for (int e = 0; e < 4; ++e) acc[e] += __shfl_xor(acc[e], 32);
    LAS float* o = sx + 256 + qd * 136;
    if (kq == 0) *(LAS f32x4*)(o + 4 * pc) = acc;
    if (lane == 0) { o[128] = m; o[129] = l; }
}
__device__ __forceinline__ void sample_combine(bf16* AOrow, bf16* COrow, int h, const LAS float* sx, int wave, int lane) {
    if (wave == 0) {
        const float l0 = sx[64], l1 = sx[72 + 64], l2 = sx[144 + 64], mm = fmaxf(fmaxf(l0, l1), l2);
        const float w0 = __expf(l0 - mm), w1 = __expf(l1 - mm), w2 = __expf(l2 - mm);
        AOrow[h * 64 + lane] = (bf16)f2bf((w0 * sx[lane] + w1 * sx[72 + lane] + w2 * sx[144 + lane]) / (w0 + w1 + w2));
    } else if (wave == 1) {
        float mm = sx[256 + 128];
#pragma unroll
        for (int qd = 1; qd < 4; ++qd) mm = fmaxf(mm, sx[256 + qd * 136 + 128]);
        float L = 0.f, a0 = 0.f, a1 = 0.f;
#pragma unroll
        for (int qd = 0; qd < 4; ++qd) { const LAS float* o = sx + 256 + qd * 136; const float w = __expf(o[128] - mm); L += w * o[129]; a0 += w * o[2 * lane]; a1 += w * o[2 * lane + 1]; }
        const float il = 1.0f / L;
        *(unsigned*)(COrow + h * 128 + 2 * lane) = pk2(a0 * il, a1 * il);
    }
}
__device__ __forceinline__ void sample_pool_fill(const bf16* Z  , const float* state, int gi, LAS unsigned char* tl, int wave, int lane) {
    const int kw = 2 << gi; const float inv = 1.0f / (float)kw;
#pragma unroll
    for (int k = 0; k < 4; ++k) { const int s = 4 * wave + k;
        const float z0 = bf2f(Z[(size_t)s * 512 + gi * 128 + lane]), z1 = bf2f(Z[(size_t)s * 512 + gi * 128 + 64 + lane]); float S0 = z0, S1 = z1;
        for (int i = 1; i < kw; ++i) { const float* sr = state + (size_t)(s * 15 + 15 - i) * 512 + gi * 128; S0 += sr[lane]; S1 += sr[64 + lane]; }
        *(LAS bf16*)(tl + s * 272 + lane * 2) = (bf16)f2bf(S0 * inv - z0); *(LAS bf16*)(tl + s * 272 + (64 + lane) * 2) = (bf16)f2bf(S1 * inv - z1); }
}

__global__ void __launch_bounds__(NWAVES * 64, 2) fwd_kernel(Args args) {
    extern __shared__ __attribute__((aligned(16))) unsigned char lds[];
    LAS unsigned char* const L = (LAS unsigned char*)lds;
    volatile LAS unsigned* MISC = (volatile LAS unsigned*)(L + MISC_OFF);
    const int tid = threadIdx.x, lane = tid & 63, wave = __builtin_amdgcn_readfirstlane(tid >> 6);
    const int G = gridDim.x, bx = blockIdx.x;
    const int vcu = (G % 8 == 0) ? (bx % 8) * (G / 8) + bx / 8 : bx;
    unsigned char* const ws = args.ws;
    gu32* ctl = (gu32*)(ws + WS_CTL);
    for (int u = tid; u < (LDS_BYTES - LDSCTL_OFF) / 4; u += NWAVES * 64) ((LAS unsigned*)(L + LDSCTL_OFF))[u] = 0u;
    __syncthreads();
    XcdBarrier bar = xcd_barrier_post((unsigned*)(ctl + CW_BAR), MISC + 8);
#define GRID_BAR() xcd_barrier(bar)
#define PHASE_IDS int tid = threadIdx.x; asm volatile("" : "+v"(tid)); const int lane = tid & 63, wave = __builtin_amdgcn_readfirstlane(tid >> 6); const int gw = vcu * NWAVES + wave; (void)lane; (void)gw
    const int NGW = G * NWAVES;
    float* const out = args.out;
    float* ssq0 = (float*)(ws + WS_SSQ0); float* ssq1 = (float*)(ws + WS_SSQ1); float* ssq2 = (float*)(ws + WS_SSQ2); float* ssq3 = (float*)(ws + WS_SSQ3); float* ssqm = (float*)(ws + WS_SSQM);
    bf16* XB = (bf16*)(ws + WS_XB); bf16* HB = (bf16*)(ws + WS_H); unsigned char* GB = (unsigned char*)(ws + WS_G); bf16* MB = (bf16*)(ws + WS_MB);

    constexpr int I_GU = 16 * 88, I_D = 44 * 32, I_IN = 16 * 200, I_MEM = 16 * 32, I_OA = 4 * 32, I_OB = 8 * 32, I_OUT = 16 * 32, I_PL = 2 * 4;
    constexpr int I_SET0 = 2 * I_GU + I_MEM, I_SET1 = I_D + I_IN + I_OA + 2 * I_OB + I_OUT + 4 * I_PL, I_SET2 = 3 * I_GU;
    static_assert(I_GU == I_D, "items");
#define CONVERT_ITEM(it_) do { int r = (it_); LAS float* scr = (LAS float*)(L + wave * 16384); \
        if (r < I_GU) { p0_matrix_item(args.in[10], 1024, 2816, args.in[9], (bf16*)(ws + WS_W1GU), 1, r, scr, lane); break; } r -= I_GU; \
        if (r < I_GU) { p0_matrix_item(args.in[11], 1024, 2816, args.in[9], (bf16*)(ws + WS_W1GU), 2, r, scr, lane); break; } r -= I_GU; \
        if (r < I_MEM) { p0_matrix_item(args.in[18], 1024, 1024, args.in[17], (bf16*)(ws + WS_WMEM), 0, r, scr, lane); break; } r -= I_MEM; \
        if (r < I_D) { p0_matrix_item(args.in[12], 2816, 1024, nullptr, (bf16*)(ws + WS_W1D), 0, r, scr, lane); break; } r -= I_D; \
        if (r < I_IN) { p0_matrix_item(args.in[14], 1024, 6400, args.in[13], (bf16*)(ws + WS_WIN), 0, r, scr, lane); break; } r -= I_IN; \
        if (r < I_OA) { p0_matrix_item_cat(args.in[19], 256, 1024, (bf16*)(ws + WS_WOA), KCAT, 0, r, scr, lane); break; } r -= I_OA; \
        if (r < I_OB) { p0_matrix_item_cat(args.in[20], 512, 1024, (bf16*)(ws + WS_WOA), KCAT, 256, r, scr, lane); break; } r -= I_OB; \
        if (r < I_OB) { p0_matrix_item_cat(args.in[21], 512, 1024, (bf16*)(ws + WS_WOA), KCAT, 768, r, scr, lane); break; } r -= I_OB; \
        if (r < I_OUT) { p0_matrix_item(args.in[22], 1024, 1024, nullptr, (bf16*)(ws + WS_WOUT), 0, r, scr, lane); break; } r -= I_OUT; \
        if (r < 4 * I_PL) { const int g_ = r / I_PL; p0_matrix_item(args.in[15] + (size_t)g_ * 16384, 128, 128, nullptr, (bf16*)(ws + WS_WPOOL) + (size_t)g_ * 16384, 0, r % I_PL, scr, lane); break; } r -= 4 * I_PL; \
        if (r < I_GU) { p0_matrix_item(args.in[24], 1024, 2816, args.in[23], (bf16*)(ws + WS_W2GU), 1, r, scr, lane); break; } r -= I_GU; \
        if (r < I_GU) { p0_matrix_item(args.in[25], 1024, 2816, args.in[23], (bf16*)(ws + WS_W2GU), 2, r, scr, lane); break; } r -= I_GU; \
        p0_matrix_item(args.in[26], 2816, 1024, nullptr, (bf16*)(ws + WS_W2D), 0, r, scr, lane); } while (0)
#define CONVERT_BY_SHORT_WGS(nwg_, first_, count_, excl_) do { const int rounds_ = ((nwg_) + G - 1) / G, c0_ = (nwg_) - (rounds_ - 1) * G, c1_ = G - (excl_); \
        if (bx >= c0_ && bx < c1_) { const int nw_ = (c1_ - c0_) * NWAVES; for (int it = (bx - c0_) * NWAVES + wave; it < (count_); it += nw_) CONVERT_ITEM((first_) + it); } } while (0)
    {   PHASE_IDS;
        {
            const float* xp = args.in[0]; const float* xs = args.in[1];
            for (int m = gw; m < MROWS / 2; m += NGW) { const int m2 = m + MROWS / 2;
                const float* sa = (m < MP) ? xp + (size_t)m * D : xs + (size_t)(m - MP) * D; const float* sb = (m2 < MP) ? xp + (size_t)m2 * D : xs + (size_t)(m2 - MP) * D;
                p0_row2(sa, XB + (size_t)m * D, ssq0 + (size_t)m * 4, sb, XB + (size_t)m2 * D, ssq0 + (size_t)m2 * 4, lane); }
            for (int m = gw; m < 512; m += NGW) p0_row2(args.in[7] + (size_t)m * D, (bf16*)(ws + WS_AMEM) + (size_t)m * D, ssqm + (size_t)m * 4,
                                                        args.in[7] + (size_t)(m + 512) * D, (bf16*)(ws + WS_AMEM) + (size_t)(m + 512) * D, ssqm + (size_t)(m + 512) * 4, lane);
            for (int m = MROWS + gw; m < MPAD; m += NGW) { GAS v4u* o = (GAS v4u*)(XB + (size_t)m * D) + lane; o[0] = (v4u){0u, 0u, 0u, 0u}; o[64] = (v4u){0u, 0u, 0u, 0u};
                if (lane == 0) { *(f32x4*)(ssq0 + (size_t)m * 4) = (f32x4){1024.f, 0.f, 0.f, 0.f}; } }
        }
        for (int it = gw; it < I_SET0; it += NGW) CONVERT_ITEM(it);
        for (int i = bx * 512 + tid; i < 3 * (MPAD - MP); i += G * 512) { const int k = i / (MPAD - MP), r = MP + i % (MPAD - MP); float* s = (k == 0) ? ssq1 : (k == 1) ? ssq2 : ssq3;
            *(f32x4*)(s + (size_t)r * 4) = (r < MROWS) ? (f32x4){0.f, 0.f, 0.f, 0.f} : (f32x4){1024.f, 0.f, 0.f, 0.f}; }
        for (int i = bx * 512 + tid; i < 3 * 129 * 4; i += G * 512) { const int h = i & 3, j = (i >> 2) % 129, g = (i >> 2) / 129; const int n = j << (2 * g);
            int bk = n; if (n >= 16) { bk = 16 + (int)(log((double)n / 16.0) / log(128.0) * 16.0); if (bk > 31) bk = 31; }
            ((float*)(ws + WS_BIAS))[i] = args.in[8][bk * 12 + g * 4 + h]; }
        for (int i = bx * 512 + tid; i < 3 * 4 * TAB_N; i += G * 512) { const int idx = i % TAB_N, h = (i / TAB_N) & 3, g = i / (4 * TAB_N); const int rel = 255 - idx; float v = MASKV;
            if (rel >= 0 && rel <= 128) { const int n = rel << (2 * g); int bk = n; if (n >= 16) { bk = 16 + (int)(log((double)n / 16.0) / log(128.0) * 16.0); if (bk > 31) bk = 31; }
                v = LOG2E * args.in[8][bk * 12 + g * 4 + h]; }
            ((float*)(ws + WS_BIAS2))[i] = v; }
    }
    GRID_BAR();

    {   PHASE_IDS;
        pg8::Gemm g{XB, (const bf16*)(ws + WS_W1GU), MPAD, 2 * DFF, D}; pg8::StaticOrder S; S.init(MPAD, 2 * DFF, G, bx);
        pg8::EpiGateUp E{HB, ssq0};
        pg8::gemm_phase<pg8::EpiGateUp, pg8::StaticOrder, true, true>(L, g, S, E);
        pg8::Gemm g2{(const bf16*)(ws + WS_AMEM), (const bf16*)(ws + WS_WMEM), 1024, 1024, D}; pg8::TailOrder S2{G - 16, 16, 4, bx};
        pg8::EpiMemKV E2{out + O_MKV, (bf16*)(ws + WS_MEMKV), ssqm};
        pg8::gemm_phase<pg8::EpiMemKV, pg8::TailOrder, true, true>(L, g2, S2, E2);
        CONVERT_BY_SHORT_WGS(65 * 22, I_SET0, I_SET1, 16);
    }
    GRID_BAR();

    {   PHASE_IDS;
        pg8::Gemm g{HB, (const bf16*)(ws + WS_W1D), MP, D, DFF}; pg8::StaticOrder S; S.init(MP, D, G, bx);
        pg8::EpiResid<false> E{XB, XB, ssq1, 0.5f};
        pg8::gemm_phase<pg8::EpiResid<false>, pg8::StaticOrder, false, true>(L, g, S, E);
    }
    GRID_BAR();

    {   PHASE_IDS;
        unsigned* const cs1 = (unsigned*)(ctl + CW_SMP);
        if (bx >= G - 32) { sample_resid<DFF>(L, HB + (size_t)MP * DFF, (const bf16*)(ws + WS_W1D), args.in[1], XB + (size_t)MP * D, ssq1 + (size_t)MP * 4, 0.5f, bx - (G - 32), tid, wave, lane); wg_publish(cs1, tid); }
        pg8::Gemm g{XB, (const bf16*)(ws + WS_WIN), MPAD, INCOLS, D}; pg8::GatedOrder S; S.init(MPAD, INCOLS, G, bx); S.cnt = cs1; S.need = 32u; S.gate_pm = 64;
        pg8::EpiWin E{(bf16*)(ws + WS_QKV), (bf16*)(ws + WS_Z), (bf16*)(ws + WS_QM), GB, ssq1, out};
        static_assert(pg8::EpiWin::o_w0p == O_W0P && pg8::EpiWin::o_pp == O_PP && pg8::EpiWin::o_w0s == O_W0S && pg8::EpiWin::o_ps == O_PS, "offsets");
        pg8::gemm_phase<pg8::EpiWin, pg8::GatedOrder, true, true>(L, g, S, E);
        CONVERT_BY_SHORT_WGS(65 * 25, I_SET0 + I_SET1, I_SET2, 0);
    }
    GRID_BAR();

    {   PHASE_IDS;
        {
            LAS unsigned char* vl = L + wave * 10752; LAS float* tabL = (LAS float*)(L + 86016); LAS float* xch = (LAS float*)(L + 91136) + wave * 32;
            const bf16* QKVp = (const bf16*)(ws + WS_QKV); const float* tab2 = (const float*)(ws + WS_BIAS2);
            for (int jg = vcu; jg < 256; jg += G) {
                const int J = jg * 8 + wave, b = J >> 9, hh = (J >> 7) & 3;
                __syncthreads();
                for (int i = tid; i < 3 * TAB_N + 64; i += NWAVES * 64) tabL[i] = (i < 3 * TAB_N) ? tab2[((i / TAB_N) * 4 + hh) * TAB_N + i % TAB_N] : MASKV;
                __syncthreads();
                attn_job(QKVp, (bf16*)(ws + WS_ABC), b, hh, (J >> 2) & 31, J & 3, vl, tabL, xch, lane);
                memattn_wg((const bf16*)(ws + WS_QM), (const bf16*)(ws + WS_MEMKV), (bf16*)(ws + WS_ABC) + 768, b, hh, J & 127, L, xch, tid, lane);
                __syncthreads();
                if (bx >= 128 || G != 256) { pool_job((const bf16*)(ws + WS_Z), (const bf16*)(ws + WS_WPOOL), args.in[16], (bf16*)(ws + WS_ABC) + 256, 32 * (J >> 2), J & 3, vl, lane);
                    if (G == 256) { const int J2 = J - 128; __syncthreads(); pool_job((const bf16*)(ws + WS_Z), (const bf16*)(ws + WS_WPOOL), args.in[16], (bf16*)(ws + WS_ABC) + 256, 32 * (J2 >> 2), J2 & 3, vl, lane); } }
            }
        }
        {
            LAS float* sx = (LAS float*)(L + 94208); LAS unsigned char* ptile = L + 102400;
            const int sp = bx - 128, ss = sp >> 2, sh = sp & 3;
            if (bx >= 128 && bx < 256) {
                if (wave < 3) sample_attn_group((const bf16*)(ws + WS_QKV) + (size_t)(MP + ss) * 2304, args.in[2 + wave], (const float*)(ws + WS_BIAS), ss, sh, wave, sx, lane);
                else if (wave < 7) sample_mem_quarter((const bf16*)(ws + WS_QM) + (size_t)(MP + ss) * 512, args.in[6], ss, sh, wave - 3, sx, lane);
            } else if (bx < 4) sample_pool_fill((const bf16*)(ws + WS_Z) + (size_t)MP * 512, args.in[5], bx, ptile, wave, lane);
            __syncthreads();
            if (bx >= 128 && bx < 256) sample_combine((bf16*)(ws + WS_ABC) + (size_t)(MP + ss) * KCAT, (bf16*)(ws + WS_ABC) + (size_t)(MP + ss) * KCAT + 768, sh, sx, wave, lane);
            else if (bx < 4 && wave == 0) pool_mma(ptile, (const bf16*)(ws + WS_WPOOL), args.in[16], (bf16*)(ws + WS_ABC) + 256, MP, bx, lane);
        }
    }
    GRID_BAR();

    {   PHASE_IDS;
        pg8::StaticOrder S; S.init(MP, D, G, bx);
        { pg8::Gemm g{(const bf16*)(ws + WS_ABC), (const bf16*)(ws + WS_WOA), MP, D, KCAT}; pg8::EpiMergeH E{GB, MB}; pg8::gemm_phase<pg8::EpiMergeH, pg8::StaticOrder, false, true>(L, g, S, E); }
    }
    GRID_BAR();

    {   PHASE_IDS;
        pg8::Gemm g{MB, (const bf16*)(ws + WS_WOUT), MP, D, D}; pg8::StaticOrder S; S.init(MP, D, G, bx);
        pg8::EpiResid<false> E{XB, XB, ssq2, 1.0f};
        pg8::gemm_phase<pg8::EpiResid<false>, pg8::StaticOrder, false, true>(L, g, S, E);
    }
    GRID_BAR();

    {   PHASE_IDS;
        unsigned* const cs2 = (unsigned*)(ctl + CW_SMP + 64); unsigned* const cs3 = (unsigned*)(ctl + CW_SMP + 128);
        if (bx >= G - 32) { const int ct = bx - (G - 32);
            float mv[2] = {0.f, 0.f};
            { mini_gemm32<256>(L, (const bf16*)(ws + WS_ABC) + (size_t)MP * KCAT, (const bf16*)(ws + WS_WOA), 32 * ct, wave, lane, KCAT, KCAT);
#pragma unroll
              for (int i = 0; i < 2; ++i) { int row, col; const float v = mini_elem(L, tid, i, row, col); mv[i] += (float)GB[(size_t)(MP + row) * 3072 + 32 * ct + col] * (1.0f / 255.0f) * v; }
              __syncthreads(); }
#pragma unroll
            for (int b = 1; b < 3; ++b) { const int ko = (b == 1) ? 256 : 768;
                mini_gemm32<512>(L, (const bf16*)(ws + WS_ABC) + (size_t)MP * KCAT + ko, (const bf16*)(ws + WS_WOA) + ko, 32 * ct, wave, lane, KCAT, KCAT);
#pragma unroll
                for (int i = 0; i < 2; ++i) { int row, col; const float v = mini_elem(L, tid, i, row, col); mv[i] += (float)GB[(size_t)(MP + row) * 3072 + b * 1024 + 32 * ct + col] * (1.0f / 255.0f) * v; }
                __syncthreads(); }
#pragma unroll
            for (int i = 0; i < 2; ++i) { const int r = (tid >> 6) + 8 * i, l = tid & 63, row = (r & 3) + 8 * (r >> 2) + 4 * (l >> 5), col = l & 31; MB[(size_t)(MP + row) * 1024 + 32 * ct + col] = (bf16)f2bf(mv[i]); }
            wg_publish(cs2, tid); wg_wait(cs2, 32u, tid);
            sample_resid<D>(L, MB + (size_t)MP * D, (const bf16*)(ws + WS_WOUT), nullptr, XB + (size_t)MP * D, ssq2 + (size_t)MP * 4, 1.0f, ct, tid, wave, lane);
            wg_publish(cs3, tid);
        }
        pg8::Gemm g{XB, (const bf16*)(ws + WS_W2GU), MPAD, 2 * DFF, D}; pg8::GatedOrder S; S.init(MPAD, 2 * DFF, G, bx); S.cnt = cs3; S.need = 32u; S.gate_pm = 64;
        pg8::EpiGateUp E{HB, ssq2};
        pg8::gemm_phase<pg8::EpiGateUp, pg8::GatedOrder, true, true>(L, g, S, E);
    }
    GRID_BAR();

    {   PHASE_IDS;
        pg8::Gemm g{HB, (const bf16*)(ws + WS_W2D), MP, D, DFF}; pg8::StaticOrder S; S.init(MP, D, G, bx);
        pg8::EpiFinal E{XB, out, args.in[27], ssq3, (unsigned*)(ctl + CW_FIN), 0.5f};
        pg8::gemm_phase<pg8::EpiFinal, pg8::StaticOrder, false, true>(L, g, S, E);
        if (bx < 32) sample_final<DFF>(L, HB + (size_t)MP * DFF, (const bf16*)(ws + WS_W2D), XB + (size_t)MP * D, out + (size_t)MP * D, args.in[27], ssq3 + (size_t)MP * 4, (unsigned*)(ctl + CW_FINS), 0.5f, bx, tid, wave, lane);
    }
}

extern "C" void kernel_launch(void* const* d_in, const int* in_sizes, int n_in, void* d_out, int out_size, void* d_ws, size_t ws_size, hipStream_t stream) {
    static int grid = 0;
    if (grid == 0) {
        if (n_in != 28 || out_size != (int)O_END || ws_size < WS_END) { fprintf(stderr, "kernel_launch: unexpected shapes: n_in %d out %d (want %zu) ws %zu (want %zu)\n", n_in, out_size, (size_t)O_END, ws_size, (size_t)WS_END); grid = -1; return; }
        int dev = 0, cus = 0;
        if (hipGetDevice(&dev) != hipSuccess || hipDeviceGetAttribute(&cus, hipDeviceAttributeMultiprocessorCount, dev) != hipSuccess) { grid = -1; return; }
        if (hipFuncSetAttribute((const void*)fwd_kernel, hipFuncAttributeMaxDynamicSharedMemorySize, LDS_BYTES) != hipSuccess) { fprintf(stderr, "kernel_launch: hipFuncSetAttribute failed\n"); grid = -1; return; }
        int per_cu = 0;
        if (hipOccupancyMaxActiveBlocksPerMultiprocessor(&per_cu, (const void*)fwd_kernel, NWAVES * 64, LDS_BYTES) != hipSuccess || per_cu < 1) fprintf(stderr, "kernel_launch: occupancy query reports %d\n", per_cu);
        (void)hipGetLastError();
        grid = cus;
        if (grid != 256) fprintf(stderr, "kernel_launch: built for 256 CUs, device has %d\n", grid);
    }
    if (grid < 0) return;
    if (hipMemsetAsync((char*)d_ws + WS_CTL, 0, CTL_ZERO_BYTES, stream) != hipSuccess) return;
    Args a{};
    for (int i = 0; i < 28; ++i) a.in[i] = (const float*)d_in[i];
    a.out = (float*)d_out; a.ws = (unsigned char*)d_ws;
    hipLaunchKernelGGL(fwd_kernel, dim3(grid), dim3(NWAVES * 64), LDS_BYTES, stream, a);
}
```

```cpp
#include <hip/hip_runtime.h>
#include <cstdio>
#include <cstdint>
#include <cmath>
namespace pg8 {
#define PG8_LAS __attribute__((address_space(3)))
typedef unsigned short bf16_t;
typedef short bf16x8 __attribute__((ext_vector_type(8)));
typedef float f32x4 __attribute__((ext_vector_type(4)));
typedef unsigned u32x4 __attribute__((ext_vector_type(4)));
constexpr int BM = 256, BK = 64, HALF = 128, HTB = HALF * BK * 2  , STAGE_BYTES = 8 * HTB, NXCD = 8, WGM = 8, AUX_OFF = STAGE_BYTES + 1024;

__host__ __device__ __forceinline__ int lds_byte(int r, int c) { const int st = (r >> 4) * 2 + (c >> 5), rr = r & 15, cc = c & 31, ob = rr * 64 + cc * 2; return st * 1024 + (ob ^ (((ob >> 9) & 1) << 5)); }
__host__ __device__ __forceinline__ void stage_rc(int b, int& R, int& C) { const int st = b / 1024, sb = b % 1024, swz = sb ^ (((sb >> 9) & 1) << 5); R = (st >> 1) * 16 + swz / 64; C = (st & 1) * 32 + (swz % 64) / 2; }
__host__ __device__ __forceinline__ int perm32(int rho) { const int n = rho >> 4, i = rho & 15; return 8 * (i >> 2) + 4 * n + (i & 3); }

struct Unit { int pm, pn; };
struct Gemm { const bf16_t* A; const bf16_t* Bt; int M, N, K; };

struct StaticOrder {
    int nM, nN, nwg, G, c;
    __host__ __device__ void init(int M, int N, int G_, int c_) { nM = M / BM; nN = N / BM; nwg = nM * nN; G = G_; c = c_; }
    __host__ __device__ bool next(int i, Unit& u) const {
        const long L = (long)i * G + c; if (L >= nwg) return false;
        int wgid = (int)L; { const int q = nwg / NXCD, r = nwg % NXCD, xcd = wgid % NXCD, off = wgid / NXCD; wgid = (xcd < r ? xcd * (q + 1) : r * (q + 1) + (xcd - r) * q) + off; }
        const int nig = WGM * nN, gid = wgid / nig, fm = gid * WGM, gsz = (nM - fm) < WGM ? (nM - fm) : WGM;
        u.pm = fm + ((wgid % nig) % gsz); u.pn = (wgid % nig) / gsz; return true;
    }
    __device__ __forceinline__ void a_ready(const Unit&) const {}
    __device__ __forceinline__ void done(const Unit&) const {}
};

typedef float f32x2_t __attribute__((ext_vector_type(2))); typedef __bf16 bf16x2_t __attribute__((ext_vector_type(2)));
__device__ __forceinline__ unsigned cvt_pk_bf16(float lo, float hi) { const f32x2_t v = {lo, hi}; const bf16x2_t b = __builtin_convertvector(v, bf16x2_t); return __builtin_bit_cast(unsigned, b); }
typedef float f32x2 __attribute__((ext_vector_type(2)));

constexpr int P_MP = 16384, P_MROWS = 16416, P_DFF = 2816;
__device__ __forceinline__ float row_rinv(const float* ssq, int row) { const f32x4 s = *(const f32x4*)(ssq + (size_t)row * 4); return rsqrtf(((s[0] + s[1]) + (s[2] + s[3])) * (1.0f / 1024.0f) + 1e-6f); }
__device__ __forceinline__ float aux_rinv(const PG8_LAS unsigned char* aux, int lrow) { const f32x4 s = *(const PG8_LAS f32x4*)(aux + lrow * 16); return rsqrtf(((s[0] + s[1]) + (s[2] + s[3])) * (1.0f / 1024.0f) + 1e-6f); }
__device__ __forceinline__ void prep_ssq(const float* ssq, PG8_LAS unsigned char* aux, const Unit& u, int wid, int lane) {
    if (wid < 4) __builtin_amdgcn_global_load_lds((const unsigned*)(ssq + (size_t)(u.pm * BM + wid * 64 + lane) * 4), (PG8_LAS unsigned*)(aux + wid * 1024), 16, 0, 0);
}
__device__ __forceinline__ float fast_sigmoid(float v) { return __builtin_amdgcn_rcpf(1.0f + __builtin_amdgcn_exp2f(v * -1.4426950408889634f)); }
__device__ __forceinline__ u32x4 pack8(const f32x4 a, const f32x4 b) { u32x4 w; w.x = cvt_pk_bf16(a[0], a[1]); w.y = cvt_pk_bf16(a[2], a[3]); w.z = cvt_pk_bf16(b[0], b[1]); w.w = cvt_pk_bf16(b[2], b[3]); return w; }
typedef unsigned u32x2 __attribute__((ext_vector_type(2)));
__device__ __forceinline__ float u8f(unsigned w, int k) { return (float)((w >> (8 * k)) & 0xffu); }
__device__ __forceinline__ float bf_lo(unsigned w) { return __uint_as_float(w << 16); }
__device__ __forceinline__ float bf_hi(unsigned w) { return __uint_as_float(w & 0xffff0000u); }

struct EpiGateUp {
    static constexpr bool PERM = true, AFTER_DRAIN = false, PREP = true, KHOOK = false;
    bf16_t* H; const float* ssq;
    __device__ __forceinline__ void prep(PG8_LAS unsigned char* aux, const Unit& u, int wid, int lane) const { prep_ssq(ssq, aux, u, wid, lane); }
    __device__ __forceinline__ void operator()(const f32x4 (&acc)[2][2][4][2], const Unit& u, int wr, int wc, int fr, int fq, const PG8_LAS unsigned char* aux) const {
        const int row0 = u.pm * BM + wr * 64 + fr, col0 = u.pn * HALF + wc * 32 + 8 * fq;
#pragma unroll
        for (int ai = 0; ai < 2; ++ai)
#pragma unroll
            for (int m = 0; m < 4; ++m) { const int row = row0 + ai * HALF + m * 16; const float ri = aux_rinv(aux, ai * HALF + wr * 64 + m * 16 + fr);
                f32x4 hv[2];
#pragma unroll
                for (int n = 0; n < 2; ++n) { const f32x4 g = acc[ai][0][m][n] * ri, up = acc[ai][1][m][n] * ri;
#pragma unroll
                    for (int j = 0; j < 4; ++j) hv[n][j] = g[j] * fast_sigmoid(g[j]) * up[j]; }
                *(u32x4*)(H + (size_t)row * P_DFF + col0) = pack8(hv[0], hv[1]); }
    }
};

struct EpiWin {
    static constexpr bool PERM = true, AFTER_DRAIN = false, PREP = true, KHOOK = false;
    bf16_t* QKV; bf16_t* Z; bf16_t* QM; unsigned char* G; const float* ssq; float* out;
    __device__ __forceinline__ void prep(PG8_LAS unsigned char* aux, const Unit& u, int wid, int lane) const { prep_ssq(ssq, aux, u, wid, lane); }
    static constexpr size_t o_w0p = (size_t)P_MROWS * 1024, o_pp = o_w0p + 262144 + 1048576 + 4194304, o_w0s = o_pp + 30720 + 1048576, o_ps = o_w0s + 3 * 16384;
    __device__ __forceinline__ void operator()(const f32x4 (&acc)[2][2][4][2], const Unit& u, int wr, int wc, int fr, int fq, const PG8_LAS unsigned char* aux) const {
        const int row0 = u.pm * BM + wr * 64 + fr, pn = u.pn;
#pragma unroll
        for (int ai = 0; ai < 2; ++ai)
#pragma unroll
            for (int m = 0; m < 4; ++m) { const int row = row0 + ai * HALF + m * 16; if (row >= P_MROWS) continue; const float ri = aux_rinv(aux, ai * HALF + wr * 64 + m * 16 + fr);
#pragma unroll
                for (int bj = 0; bj < 2; ++bj) { const int cl = bj * HALF + wc * 32 + 8 * fq;
                    f32x4 v0 = acc[ai][bj][m][0] * ri, v1 = acc[ai][bj][m][1] * ri;
                    if (pn < 9) {
                        if (pn >= 3) {
                            const int g = pn % 3, kv = (pn >= 6) ? 1 : 0, W = (g == 0) ? 128 : (g == 1) ? 512 : 2048; const size_t owp = o_w0p + (g >= 1 ? 262144u : 0u) + (g >= 2 ? 1048576u : 0u), ows = o_w0s + (size_t)g * 16384;
                            float* dst = nullptr;
                            if (row < P_MP) { const int b = row >> 12, t = row & 4095; if (t >= 4096 - W) dst = out + owp + ((size_t)(b * W + (t - (4096 - W))) * 2 + kv) * 256 + cl; }
                            else dst = out + ows + ((size_t)(row - P_MP) * 2 + kv) * 256 + cl;
                            if (dst) { *(f32x4*)dst = v0; *(f32x4*)(dst + 4) = v1; }
                        } else { v0 = v0 * 0.125f; v1 = v1 * 0.125f; }
                        *(u32x4*)(QKV + (size_t)row * 2304 + pn * 256 + cl) = pack8(v0, v1);
                    } else if (pn < 11) {
                        const int c = (pn - 9) * 256 + cl; *(u32x4*)(Z + (size_t)row * 512 + c) = pack8(v0, v1);
                        float* dst = nullptr;
                        if (row < P_MP) { const int b = row >> 12, t = row & 4095; if (t >= 4096 - 15) dst = out + o_pp + (size_t)(b * 15 + (t - (4096 - 15))) * 512 + c; }
                        else dst = out + o_ps + (size_t)(row - P_MP) * 512 + c;
                        if (dst) { *(f32x4*)dst = v0; *(f32x4*)(dst + 4) = v1; }
                    } else if (pn < 13) {
                        const float sc = 0.08838834764831845f; v0 = v0 * sc; v1 = v1 * sc;
                        *(u32x4*)(QM + (size_t)row * 512 + (pn - 11) * 256 + cl) = pack8(v0, v1);
                    } else {
#pragma unroll
                        for (int j = 0; j < 4; ++j) { v0[j] = fmaxf(fast_sigmoid(v0[j]) * 255.0f + 0.5f, 1.0f); v1[j] = fmaxf(fast_sigmoid(v1[j]) * 255.0f + 0.5f, 1.0f); }
                        u32x2 gb; gb.x = (unsigned)v0[0] | ((unsigned)v0[1] << 8) | ((unsigned)v0[2] << 16) | ((unsigned)v0[3] << 24); gb.y = (unsigned)v1[0] | ((unsigned)v1[1] << 8) | ((unsigned)v1[2] << 16) | ((unsigned)v1[3] << 24);
                        *(u32x2*)(G + (size_t)row * 3072 + (pn - 13) * 256 + cl) = gb;
                    } } }
    }
};

struct EpiMemKV {
    static constexpr bool PERM = true, AFTER_DRAIN = false, PREP = true, KHOOK = false;
    float* out; bf16_t* KVb; const float* ssq;
    __device__ __forceinline__ void prep(PG8_LAS unsigned char* aux, const Unit& u, int wid, int lane) const { prep_ssq(ssq, aux, u, wid, lane); }
    __device__ __forceinline__ void operator()(const f32x4 (&acc)[2][2][4][2], const Unit& u, int wr, int wc, int fr, int fq, const PG8_LAS unsigned char* aux) const {
        const int row0 = u.pm * BM + wr * 64 + fr;
#pragma unroll
        for (int ai = 0; ai < 2; ++ai)
#pragma unroll
            for (int m = 0; m < 4; ++m) { const int row = row0 + ai * HALF + m * 16; const float ri = aux_rinv(aux, ai * HALF + wr * 64 + m * 16 + fr);
#pragma unroll
                for (int bj = 0; bj < 2; ++bj) { const int col = u.pn * BM + bj * HALF + wc * 32 + 8 * fq; const f32x4 v0 = acc[ai][bj][m][0] * ri, v1 = acc[ai][bj][m][1] * ri;
                    float* dst = out + (size_t)row * 1024 + col; *(f32x4*)dst = v0; *(f32x4*)(dst + 4) = v1;
                    *(u32x4*)(KVb + (size_t)row * 1024 + col) = pack8(v0, v1); } }
    }
};

struct EpiMergeH {
    static constexpr bool PERM = true, AFTER_DRAIN = false, PREP = false, KHOOK = true;
    static constexpr int KT1 = 4, KT2 = 12;
    const unsigned char* G; bf16_t* Mb;
    __device__ __forceinline__ void khook(f32x4 (&acc)[2][2][4][2], const Unit& u, int t, int wr, int wc, int fr, int fq) const {
        const unsigned char* Gn = G + (t == KT1 ? 0 : 1024) + (size_t)(u.pm * BM) * 3072 + u.pn * BM;
        const unsigned lo = (unsigned)(wr * 64 + fr) * 3072u + (unsigned)(wc * 32 + 8 * fq);
#pragma unroll
        for (int ai = 0; ai < 2; ++ai)
#pragma unroll
            for (int mh = 0; mh < 2; ++mh) {
                u32x2 gn[2][2], gd[2][2];
#pragma unroll
                for (int mm = 0; mm < 2; ++mm)
#pragma unroll
                    for (int bj = 0; bj < 2; ++bj) { const unsigned o = lo + (unsigned)((ai * HALF + (2 * mh + mm) * 16) * 3072 + bj * HALF); gn[mm][bj] = *(const u32x2*)(Gn + o); gd[mm][bj] = *(const u32x2*)(Gn + 1024 + o); }
                asm volatile("" ::: "memory");
#pragma unroll
                for (int mm = 0; mm < 2; ++mm)
#pragma unroll
                    for (int bj = 0; bj < 2; ++bj) { const u32x2 a = gn[mm][bj], b = gd[mm][bj]; const int m = 2 * mh + mm;
#pragma unroll
                        for (int j = 0; j < 4; ++j) { acc[ai][bj][m][0][j] *= u8f(a.x, j) * __builtin_amdgcn_rcpf(u8f(b.x, j)); acc[ai][bj][m][1][j] *= u8f(a.y, j) * __builtin_amdgcn_rcpf(u8f(b.y, j)); } }
                asm volatile("" ::: "memory");
            }
    }
    __device__ __forceinline__ void operator()(const f32x4 (&acc)[2][2][4][2], const Unit& u, int wr, int wc, int fr, int fq, const PG8_LAS unsigned char*) const {
        const int row0 = u.pm * BM + wr * 64 + fr;
#pragma unroll
        for (int ai = 0; ai < 2; ++ai) {
            u32x2 gw[4][2];
#pragma unroll
            for (int m = 0; m < 4; ++m)
#pragma unroll
                for (int bj = 0; bj < 2; ++bj) gw[m][bj] = *(const u32x2*)(G + 2048 + (size_t)(row0 + ai * HALF + m * 16) * 3072 + u.pn * BM + bj * HALF + wc * 32 + 8 * fq);
            asm volatile("" ::: "memory");
#pragma unroll
            for (int m = 0; m < 4; ++m)
#pragma unroll
                for (int bj = 0; bj < 2; ++bj) { const size_t row = row0 + ai * HALF + m * 16; const int col = u.pn * BM + bj * HALF + wc * 32 + 8 * fq; const u32x2 g = gw[m][bj]; const float k255 = 1.0f / 255.0f;
                    f32x4 v0 = acc[ai][bj][m][0] * k255, v1 = acc[ai][bj][m][1] * k255;
#pragma unroll
                    for (int j = 0; j < 4; ++j) { v0[j] *= u8f(g.x, j); v1[j] *= u8f(g.y, j); }
                    *(u32x4*)(Mb + row * 1024 + col) = pack8(v0, v1); }
            asm volatile("" ::: "memory");
        }
    }
};

__device__ __forceinline__ void unpack8(const u32x4 w, f32x4& a, f32x4& b) { a[0] = bf_lo(w.x); a[1] = bf_hi(w.x); a[2] = bf_lo(w.y); a[3] = bf_hi(w.y); b[0] = bf_lo(w.z); b[1] = bf_hi(w.z); b[2] = bf_lo(w.w); b[3] = bf_hi(w.w); }
template <bool BASE_F32>
struct EpiResid {
    static constexpr bool PERM = true, AFTER_DRAIN = true, PREP = false, KHOOK = false;
    const void* base; bf16_t* xb; float* ssq_out; float scale;
    __device__ __forceinline__ void fused(f32x4 (&acc)[2][2][4][2], const Unit& u, int wr, int wc, int fr, int fq, PG8_LAS unsigned char* lds, int wid, int lane) const {
        PG8_LAS float* P = (PG8_LAS float*)lds;
        const int row0 = u.pm * BM + wr * 64 + fr;
        u32x4 raw[2][4][2];
        if (!BASE_F32) {
#pragma unroll
            for (int ai = 0; ai < 2; ++ai)
#pragma unroll
                for (int m = 0; m < 4; ++m)
#pragma unroll
                    for (int bj = 0; bj < 2; ++bj) raw[ai][m][bj] = *(const u32x4*)((const bf16_t*)base + (size_t)(row0 + ai * HALF + m * 16) * 1024 + u.pn * BM + bj * HALF + wc * 32 + 8 * fq);
            asm volatile("" ::: "memory");
        }
#pragma unroll
        for (int ai = 0; ai < 2; ++ai) {
            f32x4 pre[4][2][2];
#pragma unroll
            for (int m = 0; m < 4; ++m)
#pragma unroll
                for (int bj = 0; bj < 2; ++bj) { const size_t off = (size_t)(row0 + ai * HALF + m * 16) * 1024 + u.pn * BM + bj * HALF + wc * 32 + 8 * fq;
                    if (BASE_F32) { pre[m][bj][0] = *(const f32x4*)((const float*)base + off); pre[m][bj][1] = *(const f32x4*)((const float*)base + off + 4); }
                    else unpack8(raw[ai][m][bj], pre[m][bj][0], pre[m][bj][1]); }
            asm volatile("" ::: "memory");
#pragma unroll
            for (int m = 0; m < 4; ++m) { const int row = row0 + ai * HALF + m * 16; float s = 0.f;
#pragma unroll
                for (int bj = 0; bj < 2; ++bj) { const int col = u.pn * BM + bj * HALF + wc * 32 + 8 * fq; const size_t off = (size_t)row * 1024 + col;
                    const f32x4 v0 = pre[m][bj][0] + acc[ai][bj][m][0] * scale, v1 = pre[m][bj][1] + acc[ai][bj][m][1] * scale;
                    *(u32x4*)(xb + off) = pack8(v0, v1);
                    s += (v0[0] * v0[0] + v0[1] * v0[1]) + (v0[2] * v0[2] + v0[3] * v0[3]) + (v1[0] * v1[0] + v1[1] * v1[1]) + (v1[2] * v1[2] + v1[3] * v1[3]); }
                s += __shfl_xor(s, 16); s += __shfl_xor(s, 32);
                if (fq == 0) P[(ai * HALF + wr * 64 + m * 16 + fr) * 4 + wc] = s; }
            asm volatile("" ::: "memory"); }
        asm volatile("s_waitcnt lgkmcnt(0)" ::: "memory"); __builtin_amdgcn_s_barrier(); asm volatile("" ::: "memory");
        const int tid = wid * 64 + lane;
        if (tid < 256) { const f32x4 p = *(const PG8_LAS f32x4*)(P + tid * 4); ssq_out[(size_t)(u.pm * BM + tid) * 4 + u.pn] = (p[0] + p[1]) + (p[2] + p[3]); }
        asm volatile("s_waitcnt lgkmcnt(0)" ::: "memory"); __builtin_amdgcn_s_barrier(); asm volatile("" ::: "memory");
    }
};
struct EpiFinal {
    static constexpr bool PERM = true, AFTER_DRAIN = true, PREP = false, KHOOK = false;
    const bf16_t* base; float* out; const float* gfin; float* xbuf; unsigned* cnt; float scale;
    __device__ __forceinline__ void fused(f32x4 (&acc)[2][2][4][2], const Unit& u, int wr, int wc, int fr, int fq, PG8_LAS unsigned char* lds, int wid, int lane) const {
        PG8_LAS float* P = (PG8_LAS float*)lds;
        PG8_LAS float* S = (PG8_LAS float*)(lds + 4096);
        const int row0 = u.pm * BM + wr * 64 + fr;
#pragma unroll
        for (int ai = 0; ai < 2; ++ai) {
            f32x4 pre[4][2][2];
#pragma unroll
            for (int m = 0; m < 4; ++m)
#pragma unroll
                for (int bj = 0; bj < 2; ++bj) { const size_t off = (size_t)(row0 + ai * HALF + m * 16) * 1024 + u.pn * BM + bj * HALF + wc * 32 + 8 * fq; unpack8(*(const u32x4*)(base + off), pre[m][bj][0], pre[m][bj][1]); }
            asm volatile("" ::: "memory");
#pragma unroll
            for (int m = 0; m < 4; ++m) { const int row = row0 + ai * HALF + m * 16; float s = 0.f; (void)row;
#pragma unroll
                for (int bj = 0; bj < 2; ++bj) {
                    const f32x4 v0 = pre[m][bj][0] + acc[ai][bj][m][0] * scale, v1 = pre[m][bj][1] + acc[ai][bj][m][1] * scale;
                    acc[ai][bj][m][0] = v0; acc[ai][bj][m][1] = v1;
                    s += (v0[0] * v0[0] + v0[1] * v0[1]) + (v0[2] * v0[2] + v0[3] * v0[3]) + (v1[0] * v1[0] + v1[1] * v1[1]) + (v1[2] * v1[2] + v1[3] * v1[3]); }
                s += __shfl_xor(s, 16); s += __shfl_xor(s, 32);
                if (fq == 0) P[(ai * HALF + wr * 64 + m * 16 + fr) * 4 + wc] = s; }
            asm volatile("" ::: "memory"); }
        asm volatile("s_waitcnt lgkmcnt(0)" ::: "memory"); __builtin_amdgcn_s_barrier(); asm volatile("" ::: "memory");
        const int tid = wid * 64 + lane;
        if (tid < 256) { const f32x4 p = *(const PG8_LAS f32x4*)(P + tid * 4);
            __hip_atomic_store(xbuf + (size_t)(u.pm * BM + tid) * 4 + u.pn, (p[0] + p[1]) + (p[2] + p[3]), __ATOMIC_RELAXED, __HIP_MEMORY_SCOPE_AGENT); }
        asm volatile("s_waitcnt vmcnt(0)" ::: "memory");
        if (lane == 0) __hip_atomic_fetch_add(cnt + 64 * u.pm, 1u, __ATOMIC_RELAXED, __HIP_MEMORY_SCOPE_AGENT);
        if (wid == 0) {
            unsigned sp = 0;
            while ((unsigned)__builtin_amdgcn_readfirstlane(__hip_atomic_load(cnt + 64 * u.pm, __ATOMIC_RELAXED, __HIP_MEMORY_SCOPE_AGENT)) < 32u) { __builtin_amdgcn_s_sleep(1); if (++sp > (1u << 24)) break; }
        }
        asm volatile("s_waitcnt vmcnt(0) lgkmcnt(0)" ::: "memory"); __builtin_amdgcn_s_barrier(); asm volatile("" ::: "memory");
        if (tid < 256) { const float* xp = xbuf + (size_t)(u.pm * BM + tid) * 4;
            const float a = __hip_atomic_load(xp, __ATOMIC_RELAXED, __HIP_MEMORY_SCOPE_AGENT), b = __hip_atomic_load(xp + 1, __ATOMIC_RELAXED, __HIP_MEMORY_SCOPE_AGENT),
                        c = __hip_atomic_load(xp + 2, __ATOMIC_RELAXED, __HIP_MEMORY_SCOPE_AGENT), d = __hip_atomic_load(xp + 3, __ATOMIC_RELAXED, __HIP_MEMORY_SCOPE_AGENT);
            S[tid] = rsqrtf(((a + b) + (c + d)) * (1.0f / 1024.0f) + 1e-6f); }
        asm volatile("s_waitcnt vmcnt(0) lgkmcnt(0)" ::: "memory"); __builtin_amdgcn_s_barrier(); asm volatile("" ::: "memory");
#pragma unroll
        for (int bj = 0; bj < 2; ++bj) { const int col = u.pn * BM + bj * HALF + wc * 32 + 8 * fq; const f32x4 g0 = *(const f32x4*)(gfin + col), g1 = *(const f32x4*)(gfin + col + 4);
#pragma unroll
            for (int ai = 0; ai < 2; ++ai)
#pragma unroll
                for (int m = 0; m < 4; ++m) { const int lr = ai * HALF + wr * 64 + m * 16 + fr; const float ri = S[lr]; const size_t off = (size_t)(u.pm * BM + lr) * 1024 + col;
                    *(f32x4*)(out + off) = acc[ai][bj][m][0] * ri * g0; *(f32x4*)(out + off + 4) = acc[ai][bj][m][1] * ri * g1; } }
        asm volatile("s_waitcnt lgkmcnt(0)" ::: "memory"); __builtin_amdgcn_s_barrier(); asm volatile("" ::: "memory");
    }
};
struct TailOrder {
    int first, count, nN, c;
    __device__ bool next(int i, Unit& u) const { const int idx = c - first; if (i != 0 || idx < 0 || idx >= count) return false; u.pm = idx / nN; u.pn = idx % nN; return true; }
    __device__ __forceinline__ void a_ready(const Unit&) const {}
    __device__ __forceinline__ void done(const Unit&) const {}
};

struct GatedOrder : StaticOrder {
    const unsigned* cnt; unsigned need; int gate_pm;
    __device__ __forceinline__ void a_ready(const Unit& u) const {
        if (u.pm != gate_pm) return;
        if (threadIdx.x < 64) {
            unsigned sp = 0;
            while ((unsigned)__builtin_amdgcn_readfirstlane(__hip_atomic_load(cnt, __ATOMIC_RELAXED, __HIP_MEMORY_SCOPE_AGENT)) < need) { __builtin_amdgcn_s_sleep(2); if (++sp > (1u << 24)) break; }
            __builtin_amdgcn_fence(__ATOMIC_ACQUIRE, "agent");
            asm volatile("s_waitcnt vmcnt(0)" ::: "memory");
        }
        asm volatile("" ::: "memory"); __builtin_amdgcn_s_barrier(); asm volatile("" ::: "memory");
    }
};
struct GatedOrderRev : GatedOrder {
    __device__ bool next(int i, Unit& u) const { if (!StaticOrder::next(i, u)) return false; u.pn = nN - 1 - u.pn; return true; }
};
template <class Epi, class Sched, bool ALIGN_EPI = false, bool SP2 = false>
__device__ __forceinline__ void gemm_phase(PG8_LAS unsigned char* lds, const Gemm g, const Sched& S, const Epi& E) {
    int tid_ = threadIdx.x; asm volatile("" : "+v"(tid_));
    const int tid = tid_, wid = __builtin_amdgcn_readfirstlane(tid >> 6), lane = tid & 63, wr = wid >> 2, wc = wid & 3, fr = lane & 15, fq = lane >> 4;
    const int K = g.K, nt = K / BK;
    unsigned voffA[2], voffB[2];
#pragma unroll
    for (int i = 0; i < 2; ++i) { int R, C; stage_rc(tid * 16 + i * 8192, R, C); const int Rb = Epi::PERM ? ((R & ~31) + perm32(R & 31)) : R;
        voffA[i] = (unsigned)(R * K + C) * 2u; voffB[i] = (unsigned)(Rb * K + C) * 2u; }
    const size_t kstep = (size_t)(BK * 2);
    const size_t hstep = (size_t)HALF * K * 2;
    const size_t tstep = 2 * hstep;
    const unsigned ldsw = (unsigned)wid * 1024u;
    const int aoff = lds_byte(wr * 64 + fr, fq * 8), boff = lds_byte(wc * 32 + fr, fq * 8);
#define PG8_SA(b, h) (((b) * 2 + (h)) * HTB)
#define PG8_SB(b, h) ((4 + (b) * 2 + (h)) * HTB)
#define PG8_STAGE(bufoff, gbase, voff) do { _Pragma("unroll") for (int _i = 0; _i < 2; ++_i) \
        __builtin_amdgcn_global_load_lds((const unsigned*)((const char*)(gbase) + (voff)[_i]), (PG8_LAS unsigned*)(lds + (bufoff) + ldsw + _i * 8192), 16, 0, 0); } while (0)
#define PG8_LDA(dst, b, h) do { _Pragma("unroll") for (int m = 0; m < 4; ++m) _Pragma("unroll") for (int k = 0; k < 2; ++k) dst[m][k] = *(const PG8_LAS bf16x8*)(lds + PG8_SA(b, h) + aoff + m * 2048 + k * 1024); } while (0)
#define PG8_LDB(dst, b, h) do { _Pragma("unroll") for (int n = 0; n < 2; ++n) _Pragma("unroll") for (int k = 0; k < 2; ++k) dst[n][k] = *(const PG8_LAS bf16x8*)(lds + PG8_SB(b, h) + boff + n * 2048 + k * 1024); } while (0)
#define PG8_MMA(ai, bj, At, Bt) do { __builtin_amdgcn_s_setprio(1); _Pragma("unroll") for (int m = 0; m < 4; ++m) _Pragma("unroll") for (int n = 0; n < 2; ++n) _Pragma("unroll") for (int k = 0; k < 2; ++k) \
        acc[ai][bj][m][n] = __builtin_amdgcn_mfma_f32_16x16x32_bf16(Bt[n][k], At[m][k], acc[ai][bj][m][n], 0, 0, 0); __builtin_amdgcn_s_setprio(0); } while (0)
#define PG8_WAIT_V(n) asm volatile("s_waitcnt vmcnt(" #n ")" ::: "memory")
#define PG8_WAIT_L(n) asm volatile("s_waitcnt lgkmcnt(" #n ")" ::: "memory")
#define PG8_BAR __builtin_amdgcn_s_barrier()
#define PG8_SCHED __builtin_amdgcn_sched_barrier(0)
    Unit cur, nxt; int ui = 0;
    if (!S.next(0, cur)) return;
    f32x4 acc[2][2][4][2];
#pragma unroll
    for (int a = 0; a < 2; ++a)
#pragma unroll
        for (int b = 0; b < 2; ++b)
#pragma unroll
            for (int m = 0; m < 4; ++m)
#pragma unroll
                for (int n = 0; n < 2; ++n) acc[a][b][m][n] = (f32x4){0.f, 0.f, 0.f, 0.f};
    bf16x8 At[4][2], B0[2][2], B1[2][2];
    const char* cA = (const char*)g.A + (size_t)cur.pm * tstep; const char* cB = (const char*)g.Bt + (size_t)cur.pn * tstep;
    S.a_ready(cur);
    PG8_LAS unsigned char* const auxb = lds + AUX_OFF;
    if constexpr (Epi::PREP) E.prep(auxb, cur, wid, lane);
    if constexpr (SP2) {
        PG8_STAGE(PG8_SB(0, 0), cB, voffB); PG8_STAGE(PG8_SB(0, 1), cB + hstep, voffB); PG8_STAGE(PG8_SA(0, 0), cA, voffA); PG8_STAGE(PG8_SA(0, 1), cA + hstep, voffA);
        if (wr == 1) PG8_BAR;
        PG8_WAIT_V(2); PG8_BAR;
        PG8_STAGE(PG8_SB(1, 0), cB + kstep, voffB); PG8_STAGE(PG8_SA(1, 0), cA + kstep, voffA); PG8_STAGE(PG8_SB(1, 1), cB + hstep + kstep, voffB);
        PG8_WAIT_V(6); PG8_BAR;
    } else {
        PG8_STAGE(PG8_SB(0, 0), cB, voffB); PG8_STAGE(PG8_SA(0, 0), cA, voffA); PG8_STAGE(PG8_SB(0, 1), cB + hstep, voffB); PG8_STAGE(PG8_SA(0, 1), cA + hstep, voffA);
        if (wr == 1) PG8_BAR;
        PG8_WAIT_V(4); PG8_BAR;
        PG8_STAGE(PG8_SB(1, 0), cB + kstep, voffB); PG8_STAGE(PG8_SA(1, 0), cA + kstep, voffA); PG8_STAGE(PG8_SB(1, 1), cB + hstep + kstep, voffB);
        PG8_WAIT_V(6); PG8_BAR;
    }
    for (;;) {
        const bool has_next = S.next(ui + 1, nxt);
        const char* nA = has_next ? (const char*)g.A + (size_t)nxt.pm * tstep : cA; const char* nB = has_next ? (const char*)g.Bt + (size_t)nxt.pn * tstep : cB;
        for (int t = 0; t < nt; t += 2) {
            const bool last = (t == nt - 2);
            if constexpr (Epi::KHOOK) { if (t == Epi::KT1 || t == Epi::KT2) E.khook(acc, cur, t, wr, wc, fr, fq); }
            const char* a1 = cA + (size_t)(t + 1) * kstep;
            const char* a2 = last ? nA : cA + (size_t)(t + 2) * kstep; const char* b2 = last ? nB : cB + (size_t)(t + 2) * kstep;
            const char* a3 = a2 + kstep; const char* b3 = b2 + kstep;
            if (last && has_next) S.a_ready(nxt);
            if constexpr (SP2) {
            PG8_LDB(B0, 0, 0); PG8_LDB(B1, 0, 1); PG8_SCHED; PG8_LDA(At, 0, 0); PG8_STAGE(PG8_SA(1, 1), a1 + hstep, voffA);
            PG8_WAIT_V(8); PG8_WAIT_L(0); PG8_BAR; PG8_MMA(0, 0, At, B0); PG8_MMA(0, 1, At, B1); PG8_BAR; PG8_SCHED;
            PG8_LDA(At, 0, 1); PG8_STAGE(PG8_SB(0, 0), b2, voffB); PG8_STAGE(PG8_SB(0, 1), b2 + hstep, voffB); PG8_STAGE(PG8_SA(0, 0), a2, voffA);
            PG8_WAIT_V(8); PG8_WAIT_L(0); PG8_BAR; PG8_MMA(1, 0, At, B0); PG8_MMA(1, 1, At, B1); PG8_BAR; PG8_SCHED;
            PG8_LDB(B0, 1, 0); PG8_LDB(B1, 1, 1); PG8_SCHED; PG8_LDA(At, 1, 0); PG8_STAGE(PG8_SA(0, 1), a2 + hstep, voffA);
            PG8_WAIT_V(8); PG8_WAIT_L(0); PG8_BAR; PG8_MMA(0, 0, At, B0); PG8_MMA(0, 1, At, B1); PG8_BAR; PG8_SCHED;
            PG8_LDA(At, 1, 1); PG8_STAGE(PG8_SB(1, 0), b3, voffB); PG8_STAGE(PG8_SB(1, 1), b3 + hstep, voffB); PG8_STAGE(PG8_SA(1, 0), a3, voffA);
            PG8_WAIT_V(8); PG8_WAIT_L(0); PG8_BAR; PG8_MMA(1, 0, At, B0); PG8_MMA(1, 1, At, B1); PG8_BAR; PG8_SCHED;
            } else {
            PG8_LDB(B0, 0, 0); PG8_SCHED; PG8_LDA(At, 0, 0); PG8_STAGE(PG8_SA(1, 1), a1 + hstep, voffA);
            PG8_WAIT_L(8); PG8_BAR; PG8_WAIT_L(0); PG8_MMA(0, 0, At, B0); PG8_BAR; PG8_SCHED;
            PG8_LDB(B1, 0, 1); PG8_STAGE(PG8_SB(0, 0), b2, voffB);
            PG8_BAR; PG8_WAIT_L(0); PG8_MMA(0, 1, At, B1); PG8_BAR;
            PG8_LDA(At, 0, 1); PG8_STAGE(PG8_SA(0, 0), a2, voffA);
            PG8_BAR; PG8_WAIT_L(0); PG8_MMA(1, 0, At, B0); PG8_BAR; PG8_SCHED;
            PG8_STAGE(PG8_SB(0, 1), b2 + hstep, voffB);
            PG8_WAIT_V(6); PG8_BAR; PG8_MMA(1, 1, At, B1); PG8_BAR;
            PG8_LDB(B0, 1, 0); PG8_SCHED; PG8_LDA(At, 1, 0); PG8_STAGE(PG8_SA(0, 1), a2 + hstep, voffA);
            PG8_WAIT_L(8); PG8_BAR; PG8_WAIT_L(0); PG8_MMA(0, 0, At, B0); PG8_BAR; PG8_SCHED;
            PG8_LDB(B1, 1, 1); PG8_STAGE(PG8_SB(1, 0), b3, voffB);
            PG8_BAR; PG8_WAIT_L(0); PG8_MMA(0, 1, At, B1); PG8_BAR;
            PG8_LDA(At, 1, 1); PG8_STAGE(PG8_SA(1, 0), a3, voffA);
            PG8_BAR; PG8_WAIT_L(0); PG8_MMA(1, 0, At, B0); PG8_BAR; PG8_SCHED;
            PG8_STAGE(PG8_SB(1, 1), b3 + hstep, voffB);
            PG8_WAIT_V(6); PG8_BAR; PG8_MMA(1, 1, At, B1); PG8_BAR;
            }
        }
        if constexpr (ALIGN_EPI) { if (wr == 0) PG8_BAR; }
        if constexpr (!Epi::AFTER_DRAIN) { E(acc, cur, wr, wc, fr, fq, auxb + (ui & 1) * 4096); S.done(cur); }
        if (!has_next) break;
#pragma unroll
        for (int a = 0; a < 2; ++a)
#pragma unroll
            for (int b = 0; b < 2; ++b)
#pragma unroll
                for (int m = 0; m < 4; ++m)
#pragma unroll
                    for (int n = 0; n < 2; ++n) acc[a][b][m][n] = (f32x4){0.f, 0.f, 0.f, 0.f};
        cur = nxt; cA = nA; cB = nB; ++ui;
        if constexpr (Epi::PREP) E.prep(auxb + (ui & 1) * 4096, cur, wid, lane);
        if constexpr (ALIGN_EPI) { if (wr == 1) PG8_BAR; }
    }
    PG8_WAIT_V(0);
    if constexpr (!ALIGN_EPI) { if (wr == 0) PG8_BAR; }
    PG8_BAR;
    if constexpr (Epi::AFTER_DRAIN) { E.fused(acc, cur, wr, wc, fr, fq, lds, wid, lane); S.done(cur); }
#undef PG8_SA
#undef PG8_SB
#undef PG8_STAGE
#undef PG8_LDA
#undef PG8_LDB
#undef PG8_MMA
#undef PG8_WAIT_V
#undef PG8_WAIT_L
#undef PG8_BAR
#undef PG8_SCHED
}
}
#define GAS __attribute__((address_space(1)))
#define LAS __attribute__((address_space(3)))
typedef unsigned short bf16;
typedef unsigned v4u __attribute__((ext_vector_type(4)));
typedef float f32x4 __attribute__((ext_vector_type(4)));
typedef short bf16x8 __attribute__((ext_vector_type(8)));
typedef GAS unsigned gu32;
typedef GAS unsigned long long gu64;
#define RLX_AGENT __ATOMIC_RELAXED, __HIP_MEMORY_SCOPE_AGENT
#define LDS_WAIT() asm volatile("s_waitcnt lgkmcnt(0)" ::: "memory")
#define VM_WAIT() asm volatile("s_waitcnt vmcnt(0)" ::: "memory")
__device__ __forceinline__ unsigned long long rt() { return __builtin_amdgcn_s_memrealtime(); }
__device__ __forceinline__ unsigned f2bf(float f) { unsigned u = __builtin_bit_cast(unsigned, f); return (u + 0x7fffu + ((u >> 16) & 1u)) >> 16; }
__device__ __forceinline__ unsigned pk2(float lo, float hi) { return f2bf(lo) | (f2bf(hi) << 16); }

#define XB_TMO      128
#define XB_XCNT(j)  (256  + 64 * (j))
#define XB_XSUB(j)  (1280 + 64 * (j))
#define XB_XGEN(j)  (2304 + 64 * (j))
#define XB_TOP      3328
#define XB_TOPGEN   3392
#define XCD_BAR_WORDS 3456
#define XB_SPIN_CAP (1u << 26)

__device__ __forceinline__ unsigned xb_ld(unsigned* p)              { return __hip_atomic_load(p, __ATOMIC_RELAXED, __HIP_MEMORY_SCOPE_AGENT); }
__device__ __forceinline__ unsigned xb_add(unsigned* p, unsigned v) { return __hip_atomic_fetch_add(p, v, __ATOMIC_RELAXED, __HIP_MEMORY_SCOPE_AGENT); }
__device__ __forceinline__ unsigned xb_xcc_id() { return (unsigned)__builtin_amdgcn_s_getreg((3 << 11) | 20) & 0xFu; }
#define XB_SPIN(cond, bar) do { unsigned _sp = 0; while (cond) { __builtin_amdgcn_s_sleep(1); \
    if ((++_sp & 255u) == 0u) { if (xb_ld(&(bar)[XB_TMO])) break; if (_sp > XB_SPIN_CAP) { atomicAdd(&(bar)[XB_TMO], 1u); break; } } } } while (0)

struct XcdBarrier {
    unsigned* bar; unsigned x;
    volatile LAS unsigned* st;
};

__device__ __forceinline__ XcdBarrier xcd_barrier_post(unsigned* bar, volatile LAS unsigned* st) {
    XcdBarrier b; b.bar = bar; b.x = xb_xcc_id(); b.st = st;
    if (threadIdx.x == 0) (void)xb_add(&bar[XB_XCNT(b.x)], 1u);
    return b;
}
__device__ __forceinline__ void xcd_barrier_complete(unsigned* bar, unsigned x, unsigned& nloc, unsigned& nx) {
    const unsigned G = gridDim.x * gridDim.y * gridDim.z;
    unsigned sum, cnt, mine, sp = 0u;
    for (;;) {
        sum = 0u; cnt = 0u; mine = 0u;
#pragma unroll
        for (unsigned j = 0; j < 16; ++j) { const unsigned c = xb_ld(&bar[XB_XCNT(j)]); sum += c; cnt += (c > 0u) ? 1u : 0u; mine = (j == x) ? c : mine; }
        if (sum == G) break;
        __builtin_amdgcn_s_sleep(1);
        if ((++sp & 255u) == 0u) { if (xb_ld(&bar[XB_TMO])) break; if (sp > XB_SPIN_CAP) { atomicAdd(&bar[XB_TMO], 1u); break; } }
    }
    nloc = mine > 0u ? mine : 1u; nx = cnt > 0u ? cnt : 1u;
}

__device__ __forceinline__ void xcd_barrier(const XcdBarrier& b) {
    asm volatile("s_waitcnt vmcnt(0)" ::: "memory");
    __syncthreads();
    if (threadIdx.x == 0) {
        unsigned* bar = b.bar;
        __builtin_amdgcn_s_waitcnt(0);
        unsigned nloc = b.st[0], nx = b.st[1];
        if (nloc == 0u) { xcd_barrier_complete(bar, b.x, nloc, nx); b.st[0] = nloc; b.st[1] = nx; }
        const unsigned old = xb_add(&bar[XB_XSUB(b.x)], 1u);
        const unsigned gen = old / nloc;
        if (old + 1u == (gen + 1u) * nloc) {
            __builtin_amdgcn_fence(__ATOMIC_RELEASE, "agent");
            asm volatile("s_waitcnt vmcnt(0)" ::: "memory");
            asm volatile("buffer_inv sc1" ::: "memory");
            const unsigned og = xb_add(&bar[XB_TOP], 1u);
            const unsigned tg = og / nx;
            if (og + 1u == (tg + 1u) * nx) xb_add(&bar[XB_TOPGEN], 1u);
            else XB_SPIN(xb_ld(&bar[XB_TOPGEN]) == tg, bar);
            asm volatile("s_waitcnt vmcnt(0)" ::: "memory");
        } else {
            asm volatile("buffer_inv sc1" ::: "memory");
            XB_SPIN(xb_ld(&bar[XB_TOPGEN]) == gen, bar);
            asm volatile("s_waitcnt vmcnt(0)" ::: "memory");
        }
    }
    __syncthreads();
}

constexpr int NWAVES = 8;
constexpr int D = 1024, NBATCH = 4, SEQ = 4096, MP = NBATCH * SEQ, MS = 32, MROWS = MP + MS, MPAD = 16640;
constexpr int DFF = 2816, INCOLS = 6400, KCAT = 1280;
static_assert(MP == pg8::P_MP && MROWS == pg8::P_MROWS && DFF == pg8::P_DFF, "constants");
constexpr size_t O_W0P = (size_t)MROWS * D, O_W1P = O_W0P + 262144, O_W2P = O_W1P + 1048576, O_PP = O_W2P + 4194304, O_MKV = O_PP + 30720,
                 O_W0S = O_MKV + 1048576, O_W1S = O_W0S + 16384, O_W2S = O_W1S + 16384, O_PS = O_W2S + 16384, O_END = O_PS + 16384;
constexpr size_t MiB = 1u << 20;
constexpr size_t WS_CTL = 0, CTL_ZERO_BYTES = MiB;
constexpr size_t WS_SSQ0 = 1 * MiB, WS_SSQ1 = WS_SSQ0 + 512 * 1024, WS_SSQ2 = 2 * MiB, WS_SSQ3 = WS_SSQ2 + 512 * 1024, WS_SSQM = 3 * MiB, WS_BIAS = WS_SSQM + 256 * 1024, WS_BIAS2 = WS_BIAS + 8192;
constexpr size_t WS_W1GU = 4 * MiB, WS_W1D = 15 * MiB, WS_WIN = WS_W1D + 5632 * 1024, WS_WMEM = 33 * MiB, WS_WOA = 35 * MiB, WS_WOB = WS_WOA + 512 * 1024, WS_WOC = WS_WOB + MiB,
                 WS_WOUT = WS_WOC + MiB, WS_W2GU = WS_WOUT + 2 * MiB, WS_W2D = WS_W2GU + 11 * MiB, WS_WPOOL = 56 * MiB;
constexpr size_t WS_AMEM = 57 * MiB, WS_MEMKV = 59 * MiB, WS_XB = 61 * MiB, WS_H = 94 * MiB, WS_QKV = WS_H, WS_QM = 298 * MiB + 512 * 1024;
constexpr size_t WS_G = 184 * MiB, WS_Z = 282 * MiB, WS_MB = 315 * MiB, WS_O3 = 315 * MiB, WS_LSE = 364 * MiB, WS_ABC = 365 * MiB, WS_END = 408 * MiB;
static_assert(WS_W1GU + 5632ull * 1024 * 2 <= WS_W1D && WS_W1D + 1024ull * 2816 * 2 <= WS_WIN && WS_WIN + 6400ull * 1024 * 2 <= WS_WMEM && WS_W2D + 1024ull * 2816 * 2 <= WS_WPOOL, "weight map");
static_assert(WS_XB + (size_t)MPAD * 1024 * 2 <= WS_H && WS_H + (size_t)MPAD * 2816 * 2 <= WS_G && WS_QKV + (size_t)MPAD * 2304 * 2 <= WS_H + (size_t)MP * 2816 * 2, "map 1");
static_assert(WS_G + (size_t)MPAD * 3072 * 2 <= WS_Z && WS_Z + (size_t)MPAD * 512 * 2 <= WS_QM && WS_QM + (size_t)MPAD * 512 * 2 <= WS_O3 && WS_MB + (size_t)MPAD * 1024 * 2 <= WS_LSE && WS_O3 + 3ull * MPAD * 256 * 4 <= WS_LSE, "map 2");
static_assert(WS_ABC + (size_t)MPAD * 1280 * 2 <= WS_END && WS_WOA + 1024ull * 1280 * 2 <= WS_WOUT, "map 3");
constexpr int CW_BAR = 4096, CW_FIN = 16384, CW_FINS = CW_FIN + 64 * 64, CW_SMP = 40960;
constexpr int RING_BYTES = 131072, LDSCTL_OFF = RING_BYTES, MISC_OFF = LDSCTL_OFF + 320, LDS_BYTES = 147456;

struct Args { const float* in[28]; float* out; unsigned char* ws; };

__device__ __forceinline__ float wave_sum(float v) {
#pragma unroll
    for (int o = 1; o < 64; o <<= 1) v += __shfl_xor(v, o);
    return v;
}
__device__ __forceinline__ float wave_max(float v) {
#pragma unroll
    for (int o = 1; o < 64; o <<= 1) v = fmaxf(v, __shfl_xor(v, o));
    return v;
}
__device__ __forceinline__ float bf2f(bf16 v) { return __uint_as_float((unsigned)v << 16); }
__device__ __forceinline__ float blo(unsigned w) { return __uint_as_float(w << 16); }
__device__ __forceinline__ float bhi(unsigned w) { return __uint_as_float(w & 0xffff0000u); }

__device__ __forceinline__ void p0_transpose_item(const float* W, int N, const float* gs, bf16* WT, int Kd, int k0, int n0, int drow0, LAS float* scr, int lane) {
    float wv[32];
#pragma unroll
    for (int i = 0; i < 32; ++i) wv[i] = __builtin_nontemporal_load(W + (size_t)(k0 + 2 * i + (lane >> 5)) * N + n0 + (lane & 31));
    if (gs) {
#pragma unroll
        for (int i = 0; i < 32; ++i) wv[i] *= gs[k0 + 2 * i + (lane >> 5)]; }
#pragma unroll
    for (int i = 0; i < 32; ++i) scr[(2 * i + (lane >> 5)) * 33 + (lane & 31)] = wv[i];
    LDS_WAIT(); asm volatile("" ::: "memory");
    const int c = lane & 7;
#pragma unroll
    for (int j = 0; j < 4; ++j) { const int n = (lane >> 3) + 8 * j; const LAS float* s = scr + (8 * c) * 33 + n;
        v4u o; o.x = pk2(s[0 * 33], s[1 * 33]); o.y = pk2(s[2 * 33], s[3 * 33]); o.z = pk2(s[4 * 33], s[5 * 33]); o.w = pk2(s[6 * 33], s[7 * 33]);
        *(GAS v4u*)(WT + (size_t)(drow0 + n) * Kd + k0 + 8 * c) = o; }
    LDS_WAIT(); asm volatile("" ::: "memory");
}
__device__ __forceinline__ void p0_matrix_item(const float* W, int K, int N, const float* gs, bf16* WT, int mode, int r, LAS float* scr, int lane) {
    const int nblk = N / 32, kb = r / nblk, nb = r % nblk, n0 = 32 * nb;
    const int drow0 = (mode == 0) ? n0 : ((n0 >> 7) * 256 + (n0 & 127) + (mode == 2 ? 128 : 0));
    p0_transpose_item(W, N, gs, WT, K, 64 * kb, n0, drow0, scr, lane);
}
__device__ __forceinline__ void p0_matrix_item_cat(const float* W, int K, int N, bf16* WT, int Kd, int kofs, int r, LAS float* scr, int lane) {
    const int nblk = N / 32, kb = r / nblk, nb = r % nblk;
    p0_transpose_item(W, N, nullptr, WT + kofs, Kd, 64 * kb, 32 * nb, 32 * nb, scr, lane);
}
__device__ __forceinline__ void p0_row2(const float* xa, bf16* oa, float* sa, const float* xb, bf16* ob, float* sb, int lane) {
    const GAS f32x4* ra = (const GAS f32x4*)xa + lane; const GAS f32x4* rb = (const GAS f32x4*)xb + lane;
    f32x4 va[4], vb[4]; float s0 = 0.f, s1 = 0.f;
#pragma unroll
    for (int j = 0; j < 4; ++j) { va[j] = __builtin_nontemporal_load(ra + 64 * j); vb[j] = __builtin_nontemporal_load(rb + 64 * j); }
#pragma unroll
    for (int j = 0; j < 4; ++j) { s0 += (va[j].x * va[j].x + va[j].y * va[j].y) + (va[j].z * va[j].z + va[j].w * va[j].w); s1 += (vb[j].x * vb[j].x + vb[j].y * vb[j].y) + (vb[j].z * vb[j].z + vb[j].w * vb[j].w); }
    s0 = wave_sum(s0); s1 = wave_sum(s1);
    GAS unsigned long long* pa = (GAS unsigned long long*)oa + lane; GAS unsigned long long* pb = (GAS unsigned long long*)ob + lane;
#pragma unroll
    for (int j = 0; j < 4; ++j) { pa[64 * j] = (unsigned long long)pk2(va[j].x, va[j].y) | ((unsigned long long)pk2(va[j].z, va[j].w) << 32);
        pb[64 * j] = (unsigned long long)pk2(vb[j].x, vb[j].y) | ((unsigned long long)pk2(vb[j].z, vb[j].w) << 32); }
    if (lane == 0) { *(f32x4*)sa = (f32x4){s0, 0.f, 0.f, 0.f}; *(f32x4*)sb = (f32x4){s1, 0.f, 0.f, 0.f}; }
}
__device__ __forceinline__ void p0_row(const float* xrow, bf16* orow, float* ssq, int lane) {
    const GAS f32x4* xr = (const GAS f32x4*)xrow + lane;
    f32x4 v[4]; float s = 0.f;
#pragma unroll
    for (int j = 0; j < 4; ++j) { v[j] = xr[64 * j]; s += (v[j].x * v[j].x + v[j].y * v[j].y) + (v[j].z * v[j].z + v[j].w * v[j].w); }
    s = wave_sum(s);
    GAS unsigned long long* o8 = (GAS unsigned long long*)orow + lane;
#pragma unroll
    for (int j = 0; j < 4; ++j) o8[64 * j] = (unsigned long long)pk2(v[j].x, v[j].y) | ((unsigned long long)pk2(v[j].z, v[j].w) << 32);
    if (lane == 0) *(f32x4*)ssq = (f32x4){s, 0.f, 0.f, 0.f};
}

typedef float f32x16 __attribute__((ext_vector_type(16)));
template <int K>
__device__ __forceinline__ void mini_gemm32(LAS unsigned char* lds, const bf16* A, const bf16* Bt, int col0, int wave, int lane, int lda = K, int ldb = K) {
    constexpr int KS = K / 8, NS = KS / 16, NB = (NS > 6) ? 6 : NS;
    const int k0 = wave * KS;
    const bf16* ap = A + (size_t)(lane & 31) * lda + k0 + 8 * (lane >> 5);
    const bf16* bp = Bt + (size_t)(col0 + (lane & 31)) * ldb + k0 + 8 * (lane >> 5);
    f32x16 acc = {0.f, 0.f, 0.f, 0.f, 0.f, 0.f, 0.f, 0.f, 0.f, 0.f, 0.f, 0.f, 0.f, 0.f, 0.f, 0.f};
#pragma unroll
    for (int s0 = 0; s0 < NS; s0 += NB) { bf16x8 av[NB], bv[NB];
#pragma unroll
        for (int j = 0; j < NB; ++j) if (s0 + j < NS) { av[j] = *(const bf16x8*)(ap + 16 * (s0 + j)); bv[j] = *(const bf16x8*)(bp + 16 * (s0 + j)); }
#pragma unroll
        for (int j = 0; j < NB; ++j) if (s0 + j < NS) acc = __builtin_amdgcn_mfma_f32_32x32x16_bf16(av[j], bv[j], acc, 0, 0, 0); }
    LAS float* part = (LAS float*)lds;
#pragma unroll
    for (int r = 0; r < 16; ++r) part[(wave * 16 + r) * 64 + lane] = acc[r];
    __syncthreads();
}
__device__ __forceinline__ float mini_elem(LAS unsigned char* lds, int tid, int i, int& row, int& col) {
    const int r = (tid >> 6) + 8 * i, l = tid & 63; const LAS float* part = (const LAS float*)lds; float v = 0.f;
#pragma unroll
    for (int w = 0; w < 8; ++w) v += part[(w * 16 + r) * 64 + l];
    row = (r & 3) + 8 * (r >> 2) + 4 * (l >> 5); col = l & 31; return v;
}
__device__ __forceinline__ float half_sum32(float s) { s += __shfl_xor(s, 1); s += __shfl_xor(s, 2); s += __shfl_xor(s, 4); s += __shfl_xor(s, 8); s += __shfl_xor(s, 16); return s; }
template <int K>
__device__ __forceinline__ void sample_resid(LAS unsigned char* lds, const bf16* A, const bf16* Bt, const float* basef, bf16* xb, float* ssq_out, float scale, int ct, int tid, int wave, int lane) {
    mini_gemm32<K>(lds, A, Bt, 32 * ct, wave, lane);
#pragma unroll
    for (int i = 0; i < 2; ++i) { int row, col; const float v = mini_elem(lds, tid, i, row, col); const size_t off = (size_t)row * 1024 + 32 * ct + col;
        const float xn = (basef ? basef[off] : bf2f(xb[off])) + scale * v; xb[off] = (bf16)f2bf(xn);
        const float s = half_sum32(xn * xn); if ((lane & 31) == 0) atomicAdd(ssq_out + row * 4 + (ct & 3), s); }
    __syncthreads();
}
template <int K>
__device__ __forceinline__ void sample_final(LAS unsigned char* lds, const bf16* A, const bf16* Bt, const bf16* base, float* out, const float* gfin, float* ssq, unsigned* cnt, float scale, int ct, int tid, int wave, int lane) {
    mini_gemm32<K>(lds, A, Bt, 32 * ct, wave, lane);
    float xn[2]; int rr[2], cc[2];
#pragma unroll
    for (int i = 0; i < 2; ++i) { const float v = mini_elem(lds, tid, i, rr[i], cc[i]); xn[i] = bf2f(base[(size_t)rr[i] * 1024 + 32 * ct + cc[i]]) + scale * v;
        const float s = half_sum32(xn[i] * xn[i]); if ((lane & 31) == 0) atomicAdd(ssq + rr[i] * 4 + (ct & 3), s); }
    asm volatile("s_waitcnt vmcnt(0)" ::: "memory");
    __syncthreads();
    if (tid == 0) { __hip_atomic_fetch_add(cnt, 1u, __ATOMIC_RELAXED, __HIP_MEMORY_SCOPE_AGENT);
        unsigned sp = 0; while (__hip_atomic_load(cnt, __ATOMIC_RELAXED, __HIP_MEMORY_SCOPE_AGENT) < 32u) { __builtin_amdgcn_s_sleep(1); if (++sp > (1u << 24)) break; } }
    __syncthreads();
#pragma unroll
    for (int i = 0; i < 2; ++i) { const float* sp4 = ssq + rr[i] * 4;
        const float a = __hip_atomic_load(sp4, __ATOMIC_RELAXED, __HIP_MEMORY_SCOPE_AGENT), b = __hip_atomic_load(sp4 + 1, __ATOMIC_RELAXED, __HIP_MEMORY_SCOPE_AGENT),
                    c = __hip_atomic_load(sp4 + 2, __ATOMIC_RELAXED, __HIP_MEMORY_SCOPE_AGENT), d = __hip_atomic_load(sp4 + 3, __ATOMIC_RELAXED, __HIP_MEMORY_SCOPE_AGENT);
        const float ri = rsqrtf(((a + b) + (c + d)) * (1.0f / 1024.0f) + 1e-6f);
        out[(size_t)rr[i] * 1024 + 32 * ct + cc[i]] = xn[i] * ri * gfin[32 * ct + cc[i]]; }
    __syncthreads();
}

__device__ __forceinline__ void wg_publish(unsigned* cnt, int tid) {
    asm volatile("s_waitcnt vmcnt(0)" ::: "memory"); __syncthreads();
    if (tid == 0) { __builtin_amdgcn_fence(__ATOMIC_RELEASE, "agent"); asm volatile("s_waitcnt vmcnt(0)" ::: "memory"); __hip_atomic_fetch_add(cnt, 1u, __ATOMIC_RELAXED, __HIP_MEMORY_SCOPE_AGENT); }
}
__device__ __forceinline__ void wg_wait(unsigned* cnt, unsigned need, int tid) {
    if (tid == 0) { unsigned sp = 0; while (__hip_atomic_load(cnt, __ATOMIC_RELAXED, __HIP_MEMORY_SCOPE_AGENT) < need) { __builtin_amdgcn_s_sleep(2); if (++sp > (1u << 24)) break; }
        __builtin_amdgcn_fence(__ATOMIC_ACQUIRE, "agent"); asm volatile("s_waitcnt vmcnt(0)" ::: "memory"); }
    __syncthreads();
}

typedef short s16x4 __attribute__((ext_vector_type(4)));
#define KO(r) (((r) & 3) + 8 * ((r) >> 2))
constexpr float LOG2E = 1.4426950408889634f;
constexpr float MASKV = -1e30f, MINIT = -5e29f;
constexpr int TAB_N = 384;
__device__ __forceinline__ s16x4 vtr(const LAS unsigned char* p) { return __builtin_bit_cast(s16x4, __builtin_amdgcn_ds_read_tr16_b64_v4i16((LAS s16x4*)p)); }

template <int DH>
__device__ __forceinline__ void attn_finish(f32x16 (&o)[DH / 32], float l, bf16* dst, size_t qstride, LAS float* xch, int lane) {
    constexpr int DB = DH / 32; const int h = lane >> 5;
    l += __shfl_xor(l, 32);
    if (h == 0) xch[lane] = 1.0f / l;
    LDS_WAIT(); asm volatile("" ::: "memory");
#pragma unroll
    for (int r = 0; r < 16; ++r) { const float il = xch[KO(r) + 4 * h]; bf16* dq = dst + qstride * (size_t)(KO(r) + 4 * h) + (lane & 31);
#pragma unroll
        for (int db = 0; db < DB; ++db) dq[32 * db] = (bf16)f2bf(o[db][r] * il); }
    asm volatile("" ::: "memory");
}
template <int DH, bool TAB>
__device__ __forceinline__ void softmax_pv(const f32x16 s, f32x16 (&o)[DH / 32], float& m, float& l, const LAS unsigned char* vt, const LAS float* tb, int kmin, LAS float* xch, int lane) {
    constexpr int DB = DH / 32, VP = DH * 2 + 64; const int h = lane >> 5;
    float x[16];
#pragma unroll
    for (int r = 0; r < 16; ++r) x[r] = TAB ? __builtin_fmaf(s[r], LOG2E, tb[KO(r)]) : s[r] * LOG2E;
    if (kmin > 0) {
#pragma unroll
        for (int r = 0; r < 16; ++r) if (KO(r) + 4 * h < kmin) x[r] = MASKV;
    }
    float bm = fmaxf(fmaxf(x[0], x[1]), fmaxf(x[2], x[3]));
#pragma unroll
    for (int r = 4; r < 16; r += 4) bm = fmaxf(bm, fmaxf(fmaxf(x[r], x[r + 1]), fmaxf(x[r + 2], x[r + 3])));
    bm = fmaxf(bm, __shfl_xor(bm, 32));
    const float mn = fmaxf(m, bm);
    if (__any(bm > m + 8.0f)) {
        const float a = __builtin_amdgcn_exp2f(m - mn); l *= a; m = mn;
        if (h == 0) xch[lane] = a;
        LDS_WAIT(); asm volatile("" ::: "memory");
#pragma unroll
        for (int r = 0; r < 16; ++r) { const float ar = xch[KO(r) + 4 * h];
#pragma unroll
            for (int db = 0; db < DB; ++db) o[db][r] *= ar; }
        asm volatile("" ::: "memory");
    }
    float ps = 0.f;
#pragma unroll
    for (int r = 0; r < 16; ++r) { x[r] = __builtin_amdgcn_exp2f(x[r] - m); ps += x[r]; }
    l += ps;
    v4u pw0, pw1;
    pw0.x = pg8::cvt_pk_bf16(x[0], x[1]); pw0.y = pg8::cvt_pk_bf16(x[2], x[3]); pw0.z = pg8::cvt_pk_bf16(x[4], x[5]); pw0.w = pg8::cvt_pk_bf16(x[6], x[7]);
    pw1.x = pg8::cvt_pk_bf16(x[8], x[9]); pw1.y = pg8::cvt_pk_bf16(x[10], x[11]); pw1.z = pg8::cvt_pk_bf16(x[12], x[13]); pw1.w = pg8::cvt_pk_bf16(x[14], x[15]);
    const bf16x8 pa0 = __builtin_bit_cast(bf16x8, pw0), pa1 = __builtin_bit_cast(bf16x8, pw1);
    const LAS unsigned char* vb = vt + (((lane & 15) >> 2) + 4 * h) * VP + (16 * ((lane >> 4) & 1) + 4 * (lane & 3)) * 2;
#pragma unroll
    for (int db = 0; db < DB; ++db) {
        const s16x4 l0 = vtr(vb + db * 64), h0 = vtr(vb + db * 64 + 8 * VP), l1 = vtr(vb + db * 64 + 16 * VP), h1 = vtr(vb + db * 64 + 24 * VP);
        const bf16x8 b0 = {l0[0], l0[1], l0[2], l0[3], h0[0], h0[1], h0[2], h0[3]}, b1 = {l1[0], l1[1], l1[2], l1[3], h1[0], h1[1], h1[2], h1[3]};
        o[db] = __builtin_amdgcn_mfma_f32_32x32x16_bf16(pa0, b0, o[db], 0, 0, 0);
        o[db] = __builtin_amdgcn_mfma_f32_32x32x16_bf16(pa1, b1, o[db], 0, 0, 0);
    }
}
struct KVBuf { v4u kr[4]; v4u vr[4]; };
__device__ __forceinline__ void attn_load64(KVBuf& B, const bf16* vp, long vstep, int imin) {
#pragma unroll
    for (int i = 0; i < 4; ++i) { const bf16* p = vp + (long)(i < imin ? imin : i) * vstep; B.kr[i] = *(const v4u*)(p - 768); B.vr[i] = *(const v4u*)p; }
}
__device__ __forceinline__ void attn_compute64(const KVBuf& B, const bf16x8 (&qf)[4], f32x16 (&o)[2], float& m, float& l, LAS unsigned char* kl  , const LAS float* tb, int kmin, LAS float* xch, int lane) {
    const int q = lane & 31, h = lane >> 5; LAS unsigned char* vl = kl + 4608;
#pragma unroll
    for (int i = 0; i < 4; ++i) { *(LAS v4u*)(kl + ((lane >> 3) + 8 * i) * 144 + (lane & 7) * 16) = B.kr[i]; *(LAS v4u*)(vl + ((lane >> 3) + 8 * i) * 192 + (lane & 7) * 16) = B.vr[i]; }
    f32x16 s = {0.f, 0.f, 0.f, 0.f, 0.f, 0.f, 0.f, 0.f, 0.f, 0.f, 0.f, 0.f, 0.f, 0.f, 0.f, 0.f};
#pragma unroll
    for (int ks = 0; ks < 4; ++ks) { const bf16x8 kf = *(const LAS bf16x8*)(kl + q * 144 + (16 * ks + 8 * h) * 2); s = __builtin_amdgcn_mfma_f32_32x32x16_bf16(kf, qf[ks], s, 0, 0, 0); }
    softmax_pv<64, true>(s, o, m, l, vl, tb, kmin, xch, lane);
}
__device__ __forceinline__ void attn_stream(f32x16 (&o)[2], float& m, float& l, const bf16x8 (&qf)[4], const bf16* vp, long vstep, const LAS float* tb, int tstep, int cnt, int kmin,
                                            LAS unsigned char* vl, LAS float* xch, int lane) {
    const long bstep = 4 * vstep;
    KVBuf A, Bb;
    attn_load64(A, vp, vstep, kmin >> 3);
    for (int i = 0; i < cnt; i += 2) {
        const bool has1 = (i + 1 < cnt), has2 = (i + 2 < cnt);
        const bf16* vp1 = has1 ? vp + bstep : vp; const bf16* vp2 = has2 ? vp + 2 * bstep : vp1;
        attn_load64(Bb, vp1, vstep, has1 ? 0 : (kmin >> 3));
        attn_compute64(A, qf, o, m, l, vl, tb, (i == 0) ? kmin : 0, xch, lane);
        attn_load64(A, vp2, vstep, (has2 || has1) ? 0 : (kmin >> 3));
        if (has1) attn_compute64(Bb, qf, o, m, l, vl, tb + tstep, 0, xch, lane);
        vp = vp2; tb += 2 * tstep;
    }
}
__device__ __forceinline__ int attn_lidx(int lt, int c0) { return 2 * (lt >> 2) + (lt & 3) - c0; }
__device__ __forceinline__ void attn_g2_job(const bf16* QKV, LAS unsigned short* Ost, LAS float* Mst, LAS float* Lst, int b, int hh, int R, int sp, int c0, LAS unsigned char* vl, const LAS float* tabL, LAS float* xch, int lane_) {
    int lane = lane_; asm volatile("" : "+v"(lane)); const int q = lane & 31, h = lane >> 5;
    const long rowb = (long)b * 4096; const int kbf = (sp < 4) ? 4 - sp : 0;
    f32x16 o[2]; float m = MINIT, l = 0.f;
#pragma unroll
    for (int r = 0; r < 16; ++r) { o[0][r] = 0.f; o[1][r] = 0.f; }
    bf16x8 qf[4];
    { const bf16* qr = QKV + (rowb + 16 * (32 * sp + q) + R) * 2304 + 512 + hh * 64 + 8 * h;
#pragma unroll
      for (int ks = 0; ks < 4; ++ks) qf[ks] = *(const bf16x8*)(qr + 16 * ks); }
    const bf16* vp = QKV + (rowb + 16 * ((long)32 * sp - 128 + 32 * kbf + (lane >> 3)) + R) * 2304 + 1536 + 512 + hh * 64 + (lane & 7) * 8;
    attn_stream(o, m, l, qf, vp, (long)128 * 2304, tabL + 2 * TAB_N + 127 + 32 * kbf + 4 * h - q, 32, 5 - kbf, 0, vl, xch, lane);
    l += __shfl_xor(l, 32);
    if (h == 0) { const int li = attn_lidx(16 * q + R, c0); Mst[li] = m; Lst[li] = l; }
#pragma unroll
    for (int r = 0; r < 16; ++r) { LAS unsigned short* dq = Ost + attn_lidx(16 * (KO(r) + 4 * h) + R, c0) * 64 + q; dq[0] = (unsigned short)f2bf(o[0][r]); dq[32] = (unsigned short)f2bf(o[1][r]); }
}
__device__ __forceinline__ void attn_g01_job(const bf16* QKV, const LAS unsigned short* Ost, const LAS float* Mst, const LAS float* Lst, bf16* AO, int b, int hh, int n, int c, int sp, int c0, LAS unsigned char* vl, const LAS float* tabL, LAS float* xch, int lane_) {
    int lane = lane_; asm volatile("" : "+v"(lane)); const int q = lane & 31, h = lane >> 5;
    const long rowb = (long)b * 4096; const int T0 = 128 * n, lt0 = 128 * (n - 4 * sp) + c;
    const int kb0 = (n == 0) ? 4 : 0, kb1 = (n < 4) ? 4 - n : 0;
    f32x16 o[2]; float m, l;
    { const int li = attn_lidx(lt0 + 4 * q, c0); m = Mst[li]; l = (h == 0) ? Lst[li] : 0.f; }
#pragma unroll
    for (int r = 0; r < 16; ++r) { const LAS unsigned short* dq = Ost + attn_lidx(lt0 + 4 * (KO(r) + 4 * h), c0) * 64 + q; o[0][r] = __builtin_bit_cast(float, (unsigned)dq[0] << 16); o[1][r] = __builtin_bit_cast(float, (unsigned)dq[32] << 16); }
    bf16x8 qf[4];
#pragma unroll
    for (int g = 0; g < 2; ++g) {
        int ln = lane; asm volatile("" : "+v"(ln)); const int q2 = ln & 31, h2 = ln >> 5;
        { const bf16* qr = QKV + (rowb + T0 + c + 4 * q2) * 2304 + hh * 64 + 8 * h2 + 256 * g;
#pragma unroll
          for (int ks = 0; ks < 4; ++ks) qf[ks] = *(const bf16x8*)(qr + 16 * ks); }
        asm volatile("" ::: "memory");
        if (g == 0) attn_stream(o, m, l, qf, QKV + (rowb + T0 - 128 + 32 * kb0 + (ln >> 3)) * 2304 + 1536 + hh * 64 + (ln & 7) * 8, (long)8 * 2304,
                                tabL + 127 + 32 * kb0 + 4 * h2 - (c + 4 * q2), 32, 8 - kb0, 0, vl, xch, ln);
        else attn_stream(o, m, l, qf, QKV + (rowb + 4 * ((long)32 * n - 128 + 32 * kb1 + (ln >> 3)) + c) * 2304 + 1536 + 256 + hh * 64 + (ln & 7) * 8, (long)32 * 2304,
                         tabL + TAB_N + 127 + 32 * kb1 + 4 * h2 - q2, 32, 5 - kb1, 0, vl, xch, ln);
    }
    attn_finish<64>(o, l, AO + (rowb + T0 + c) * KCAT + hh * 64, (size_t)4 * KCAT, xch, lane);
}
__device__ __forceinline__ void memattn_wg(const bf16* QM, const bf16* KV, bf16* CO, int b, int hh, int qb, LAS unsigned char* Lb, LAS float* xch, int tid_, int lane_) {
    int tid = tid_; asm volatile("" : "+v"(tid)); const int lane = tid & 63;
    (void)lane_; const int q = lane & 31, h = lane >> 5;
    const size_t row0 = (size_t)b * 4096 + 32 * qb;
    const bf16* qrow = QM + (row0 + q) * 512 + hh * 128 + 8 * h;
    LAS unsigned char* Kt = Lb; LAS unsigned char* Vt = Lb + 128 * 272;
    f32x16 o[4]; float m = MINIT, l = 0.f;
#pragma unroll
    for (int r = 0; r < 16; ++r) { o[0][r] = 0.f; o[1][r] = 0.f; o[2][r] = 0.f; o[3][r] = 0.f; }
    bf16x8 qf[8];
#pragma unroll
    for (int ks = 0; ks < 8; ++ks) qf[ks] = *(const bf16x8*)(qrow + 16 * ks);
    v4u kr[2][4], vr[2][4];
#pragma unroll
    for (int half = 0; half < 2; ++half)
#pragma unroll
        for (int i = 0; i < 4; ++i) { const int idx = tid + 512 * i, row = idx >> 4, pc = idx & 15; const bf16* p = KV + ((size_t)b * 256 + 128 * half + row) * 1024 + hh * 128 + pc * 8; kr[half][i] = *(const v4u*)p; vr[half][i] = *(const v4u*)(p + 512); }
#pragma unroll
    for (int half = 0; half < 2; ++half) {
        __syncthreads();
#pragma unroll
        for (int i = 0; i < 4; ++i) { const int idx = tid + 512 * i, row = idx >> 4, pc = idx & 15; *(LAS v4u*)(Kt + row * 272 + pc * 16) = kr[half][i]; *(LAS v4u*)(Vt + row * 320 + pc * 16) = vr[half][i]; }
        __syncthreads();
        for (int kb = 0; kb < 4; ++kb) {
            f32x16 s = {0.f, 0.f, 0.f, 0.f, 0.f, 0.f, 0.f, 0.f, 0.f, 0.f, 0.f, 0.f, 0.f, 0.f, 0.f, 0.f};
#pragma unroll
            for (int ks = 0; ks < 8; ++ks) { const bf16x8 kf = *(const LAS bf16x8*)(Kt + (32 * kb + q) * 272 + (16 * ks + 8 * h) * 2); s = __builtin_amdgcn_mfma_f32_32x32x16_bf16(kf, qf[ks], s, 0, 0, 0); }
            softmax_pv<128, false>(s, o, m, l, Vt + (32 * kb) * 320, nullptr, 0, xch, lane);
        }
    }
    attn_finish<128>(o, l, CO + row0 * KCAT + hh * 128, (size_t)KCAT, xch, lane);
}
__device__ __forceinline__ void pool_mma(const LAS unsigned char* tl, const bf16* WP, const float* pscale, bf16* BO, int m0, int gi, int lane) {
    constexpr int PITCH = 272; const int q = lane & 31, h = lane >> 5;
    f32x16 acc[4];
#pragma unroll
    for (int r = 0; r < 16; ++r) { acc[0][r] = 0.f; acc[1][r] = 0.f; acc[2][r] = 0.f; acc[3][r] = 0.f; }
    const bf16* wb = WP + (size_t)(gi * 128 + q) * 128 + 8 * h;
    bf16x8 bw[8][4];
#pragma unroll
    for (int ks = 0; ks < 8; ++ks)
#pragma unroll
        for (int db = 0; db < 4; ++db) bw[ks][db] = *(const bf16x8*)(wb + db * 4096 + 16 * ks);
#pragma unroll
    for (int ks = 0; ks < 8; ++ks) {
        const bf16x8 a = *(const LAS bf16x8*)(tl + q * PITCH + (16 * ks + 8 * h) * 2);
#pragma unroll
        for (int db = 0; db < 4; ++db) acc[db] = __builtin_amdgcn_mfma_f32_32x32x16_bf16(a, bw[ks][db], acc[db], 0, 0, 0); }
#pragma unroll
    for (int db = 0; db < 4; ++db) { const float sc = pscale[gi * 128 + 32 * db + q];
#pragma unroll
        for (int r = 0; r < 16; ++r) BO[(size_t)(m0 + KO(r) + 4 * h) * KCAT + gi * 128 + 32 * db + q] = (bf16)f2bf(acc[db][r] * sc); }
    LDS_WAIT(); asm volatile("" ::: "memory");
}
template <int GI>
__device__ __forceinline__ void pool_job_t(const bf16* Z, const bf16* WP, const float* pscale, bf16* BO, int m0, LAS unsigned char* tl, int lane) {
    constexpr int PITCH = 272, KW = 2 << GI, NR = 31 + KW;
    const int t0s = m0 & 4095;
    unsigned zr[NR];
#pragma unroll
    for (int i = 0; i < NR; ++i) { const int tt = i - (KW - 1); zr[i] = (t0s + tt >= 0) ? *(const unsigned*)(Z + (size_t)(m0 + tt) * 512 + GI * 128 + 2 * lane) : 0u; }
    float S0 = 0.f, S1 = 0.f;
#pragma unroll
    for (int i = 0; i < KW - 1; ++i) { S0 += blo(zr[i]); S1 += bhi(zr[i]); }
#pragma unroll
    for (int tt = 0; tt < 32; ++tt) { const unsigned w = zr[tt + KW - 1]; const float z0 = blo(w), z1 = bhi(w);
        S0 += z0; S1 += z1;
        if (tt >= 1) { S0 -= blo(zr[tt - 1]); S1 -= bhi(zr[tt - 1]); }
        const int ts = t0s + tt, cnt = (ts + 1 < KW) ? ts + 1 : KW; const float inv = 1.0f / (float)cnt;
        *(LAS unsigned*)(tl + tt * PITCH + lane * 4) = pk2(S0 * inv - z0, S1 * inv - z1); }
    LDS_WAIT(); asm volatile("" ::: "memory");
    pool_mma(tl, WP, pscale, BO, m0, GI, lane);
}
__device__ __forceinline__ void pool_job(const bf16* Z, const bf16* WP, const float* pscale, bf16* BO, int m0, int gi, LAS unsigned char* tl, int lane_) {
    int lane = lane_; asm volatile("" : "+v"(lane));
    if (gi == 0) pool_job_t<0>(Z, WP, pscale, BO, m0, tl, lane); else if (gi == 1) pool_job_t<1>(Z, WP, pscale, BO, m0, tl, lane);
    else if (gi == 2) pool_job_t<2>(Z, WP, pscale, BO, m0, tl, lane); else pool_job_t<3>(Z, WP, pscale, BO, m0, tl, lane);
}
typedef unsigned v2u __attribute__((ext_vector_type(2)));
__device__ __forceinline__ f32x4 ld_bf4(const bf16* p) { const v2u w = *(const v2u*)p; return (f32x4){blo(w.x), bhi(w.x), blo(w.y), bhi(w.y)}; }
__device__ __forceinline__ float dot4(const f32x4 a, const f32x4 b) { return (a[0] * b[0] + a[1] * b[1]) + (a[2] * b[2] + a[3] * b[3]); }
__device__ __forceinline__ void sample_attn_group(const bf16* QKVrow  , const float* cache, const float* biasT, int s, int h, int g, LAS float* sx, int lane) {
    const int kq = lane >> 4, pc = lane & 15, W = 128 << (2 * g), dil = 1 << (2 * g);
    const f32x4 q4 = ld_bf4(QKVrow + g * 256 + h * 64 + 4 * pc);
    const f32x4 kn = ld_bf4(QKVrow + 768 + g * 256 + h * 64 + 4 * pc), vn = ld_bf4(QKVrow + 1536 + g * 256 + h * 64 + 4 * pc);
    float s0 = dot4(q4, kn); s0 += __shfl_xor(s0, 1); s0 += __shfl_xor(s0, 2); s0 += __shfl_xor(s0, 4); s0 += __shfl_xor(s0, 8);
    s0 += biasT[(g * 129) * 4 + h];
    const float* cb = cache + ((size_t)s * W) * 512 + h * 64 + 4 * pc;
    float sc[32];
#pragma unroll
    for (int it = 0; it < 32; ++it) { const int j = 1 + 4 * it + kq; const f32x4 kv = __builtin_nontemporal_load((const f32x4*)(cb + (size_t)(W - dil * j) * 512));
        float d = dot4(q4, kv); d += __shfl_xor(d, 1); d += __shfl_xor(d, 2); d += __shfl_xor(d, 4); d += __shfl_xor(d, 8);
        sc[it] = d + biasT[(g * 129 + j) * 4 + h]; }
    float m = s0;
#pragma unroll
    for (int it = 0; it < 32; ++it) m = fmaxf(m, sc[it]);
    m = fmaxf(m, __shfl_xor(m, 16)); m = fmaxf(m, __shfl_xor(m, 32));
    const float p0 = __expf(s0 - m); float l = 0.f; f32x4 acc = {0.f, 0.f, 0.f, 0.f};
#pragma unroll
    for (int it = 0; it < 32; ++it) { const int j = 1 + 4 * it + kq; const float p = __expf(sc[it] - m); l += p;
        const f32x4 vv = __builtin_nontemporal_load((const f32x4*)(cb + (size_t)(W - dil * j) * 512 + 256)); acc = acc + vv * p; }
    l += __shfl_xor(l, 16); l += __shfl_xor(l, 32); l += p0;
#pragma unroll
    for (int e = 0; e < 4; ++e) { float a = acc[e]; a += __shfl_xor(a, 16); a += __shfl_xor(a, 32); acc[e] = a + p0 * vn[e]; }
    const float il = 1.0f / l;
    if (kq == 0) *(LAS f32x4*)(sx + g * 72 + 4 * pc) = acc * il;
    if (lane == 0) sx[g * 72 + 64] = m + __logf(l);
}
__device__ __forceinline__ void sample_mem_quarter(const bf16* QMrow  , const float* cache, int s, int h, int qd, LAS float* sx, int lane) {
    const int kq = lane >> 5, pc = lane & 31;
    const f32x4 q4 = ld_bf4(QMrow + h * 128 + 4 * pc);
    const float* cb = cache + ((size_t)(s * 256 + 64 * qd) * 2) * 512 + h * 128 + 4 * pc;
    float sc[32];
#pragma unroll
    for (int it = 0; it < 32; ++it) { const f32x4 kv = __builtin_nontemporal_load((const f32x4*)(cb + (size_t)(2 * it + kq) * 1024));
        float d = dot4(q4, kv); d += __shfl_xor(d, 1); d += __shfl_xor(d, 2); d += __shfl_xor(d, 4); d += __shfl_xor(d, 8); d += __shfl_xor(d, 16); sc[it] = d; }
    float m = sc[0];
#pragma unroll
    for (int it = 1; it < 32; ++it) m = fmaxf(m, sc[it]);
    m = fmaxf(m, __shfl_xor(m, 32));
    float l = 0.f; f32x4 acc = {0.f, 0.f, 0.f, 0.f};
#pragma unroll
    for (int it = 0; it < 32; ++it) { const float p = __expf(sc[it] - m); l += p; const f32x4 vv = __builtin_nontemporal_load((const f32x4*)(cb + (size_t)(2 * it + kq) * 1024 + 512)); acc = acc + vv * p; }
    l += __shfl_xor(l, 32);
#pragma unroll
    for (int e = 0; e < 4; ++e) acc[e] += __shfl_xor(acc[e], 32);
    LAS float* o = sx + 256 + qd * 136;
    if (kq == 0) *(LAS f32x4*)(o + 4 * pc) = acc;
    if (lane == 0) { o[128] = m; o[129] = l; }
}
__device__ __forceinline__ void sample_combine(bf16* AOrow, bf16* COrow, int h, const LAS float* sx, int wave, int lane) {
    if (wave == 0) {
        const float l0 = sx[64], l1 = sx[72 + 64], l2 = sx[144 + 64], mm = fmaxf(fmaxf(l0, l1), l2);
        const float w0 = __expf(l0 - mm), w1 = __expf(l1 - mm), w2 = __expf(l2 - mm);
        AOrow[h * 64 + lane] = (bf16)f2bf((w0 * sx[lane] + w1 * sx[72 + lane] + w2 * sx[144 + lane]) / (w0 + w1 + w2));
    } else if (wave == 1) {
        float mm = sx[256 + 128];
#pragma unroll
        for (int qd = 1; qd < 4; ++qd) mm = fmaxf(mm, sx[256 + qd * 136 + 128]);
        float L = 0.f, a0 = 0.f, a1 = 0.f;
#pragma unroll
        for (int qd = 0; qd < 4; ++qd) { const LAS float* o = sx + 256 + qd * 136; const float w = __expf(o[128] - mm); L += w * o[129]; a0 += w * o[2 * lane]; a1 += w * o[2 * lane + 1]; }
        const float il = 1.0f / L;
        *(unsigned*)(COrow + h * 128 + 2 * lane) = pk2(a0 * il, a1 * il);
    }
}
__device__ __forceinline__ void sample_pool_fill(const bf16* Z  , const float* state, int gi, LAS unsigned char* tl, int wave, int lane) {
    const int kw = 2 << gi; const float inv = 1.0f / (float)kw;
#pragma unroll
    for (int k = 0; k < 4; ++k) { const int s = 4 * wave + k;
        const float z0 = bf2f(Z[(size_t)s * 512 + gi * 128 + lane]), z1 = bf2f(Z[(size_t)s * 512 + gi * 128 + 64 + lane]); float S0 = z0, S1 = z1;
        for (int i = 1; i < kw; ++i) { const float* sr = state + (size_t)(s * 15 + 15 - i) * 512 + gi * 128; S0 += sr[lane]; S1 += sr[64 + lane]; }
        *(LAS bf16*)(tl + s * 272 + lane * 2) = (bf16)f2bf(S0 * inv - z0); *(LAS bf16*)(tl + s * 272 + (64 + lane) * 2) = (bf16)f2bf(S1 * inv - z1); }
}

__global__ void __launch_bounds__(NWAVES * 64, 2) fwd_kernel(Args args) {
    extern __shared__ __attribute__((aligned(16))) unsigned char lds[];
    LAS unsigned char* const L = (LAS unsigned char*)lds;
    volatile LAS unsigned* MISC = (volatile LAS unsigned*)(L + MISC_OFF);
    const int tid = threadIdx.x, lane = tid & 63, wave = __builtin_amdgcn_readfirstlane(tid >> 6);
    const int G = gridDim.x, bx = blockIdx.x;
    const int vcu = (G % 8 == 0) ? (bx % 8) * (G / 8) + bx / 8 : bx;
    unsigned char* const ws = args.ws;
    gu32* ctl = (gu32*)(ws + WS_CTL);
    for (int u = tid; u < (LDS_BYTES - LDSCTL_OFF) / 4; u += NWAVES * 64) ((LAS unsigned*)(L + LDSCTL_OFF))[u] = 0u;
    __syncthreads();
    XcdBarrier bar = xcd_barrier_post((unsigned*)(ctl + CW_BAR), MISC + 8);
#define GRID_BAR() xcd_barrier(bar)
#define PHASE_IDS int tid = threadIdx.x; asm volatile("" : "+v"(tid)); const int lane = tid & 63, wave = __builtin_amdgcn_readfirstlane(tid >> 6); const int gw = vcu * NWAVES + wave; (void)lane; (void)gw
    const int NGW = G * NWAVES;
    float* const out = args.out;
    float* ssq0 = (float*)(ws + WS_SSQ0); float* ssq1 = (float*)(ws + WS_SSQ1); float* ssq2 = (float*)(ws + WS_SSQ2); float* ssq3 = (float*)(ws + WS_SSQ3); float* ssqm = (float*)(ws + WS_SSQM);
    bf16* XB = (bf16*)(ws + WS_XB); bf16* HB = (bf16*)(ws + WS_H); unsigned char* GB = (unsigned char*)(ws + WS_G); bf16* MB = (bf16*)(ws + WS_MB);

    constexpr int I_GU = 16 * 88, I_D = 44 * 32, I_IN = 16 * 200, I_MEM = 16 * 32, I_OA = 4 * 32, I_OB = 8 * 32, I_OUT = 16 * 32, I_PL = 2 * 4;
    constexpr int I_SET0 = 2 * I_GU + I_MEM, I_SET1 = I_D + I_IN + I_OA + 2 * I_OB + I_OUT + 4 * I_PL, I_SET2 = 3 * I_GU;
    static_assert(I_GU == I_D, "items");
#define CONVERT_ITEM(it_) do { int r = (it_); LAS float* scr = (LAS float*)(L + wave * 16384); \
        if (r < I_GU) { p0_matrix_item(args.in[10], 1024, 2816, args.in[9], (bf16*)(ws + WS_W1GU), 1, r, scr, lane); break; } r -= I_GU; \
        if (r < I_GU) { p0_matrix_item(args.in[11], 1024, 2816, args.in[9], (bf16*)(ws + WS_W1GU), 2, r, scr, lane); break; } r -= I_GU; \
        if (r < I_MEM) { p0_matrix_item(args.in[18], 1024, 1024, args.in[17], (bf16*)(ws + WS_WMEM), 0, r, scr, lane); break; } r -= I_MEM; \
        if (r < I_D) { p0_matrix_item(args.in[12], 2816, 1024, nullptr, (bf16*)(ws + WS_W1D), 0, r, scr, lane); break; } r -= I_D; \
        if (r < I_IN) { p0_matrix_item(args.in[14], 1024, 6400, args.in[13], (bf16*)(ws + WS_WIN), 0, r, scr, lane); break; } r -= I_IN; \
        if (r < I_OA) { p0_matrix_item_cat(args.in[19], 256, 1024, (bf16*)(ws + WS_WOA), KCAT, 0, r, scr, lane); break; } r -= I_OA; \
        if (r < I_OB) { p0_matrix_item_cat(args.in[20], 512, 1024, (bf16*)(ws + WS_WOA), KCAT, 256, r, scr, lane); break; } r -= I_OB; \
        if (r < I_OB) { p0_matrix_item_cat(args.in[21], 512, 1024, (bf16*)(ws + WS_WOA), KCAT, 768, r, scr, lane); break; } r -= I_OB; \
        if (r < I_OUT) { p0_matrix_item(args.in[22], 1024, 1024, nullptr, (bf16*)(ws + WS_WOUT), 0, r, scr, lane); break; } r -= I_OUT; \
        if (r < 4 * I_PL) { const int g_ = r / I_PL; p0_matrix_item(args.in[15] + (size_t)g_ * 16384, 128, 128, nullptr, (bf16*)(ws + WS_WPOOL) + (size_t)g_ * 16384, 0, r % I_PL, scr, lane); break; } r -= 4 * I_PL; \
        if (r < I_GU) { p0_matrix_item(args.in[24], 1024, 2816, args.in[23], (bf16*)(ws + WS_W2GU), 1, r, scr, lane); break; } r -= I_GU; \
        if (r < I_GU) { p0_matrix_item(args.in[25], 1024, 2816, args.in[23], (bf16*)(ws + WS_W2GU), 2, r, scr, lane); break; } r -= I_GU; \
        p0_matrix_item(args.in[26], 2816, 1024, nullptr, (bf16*)(ws + WS_W2D), 0, r, scr, lane); } while (0)
#define CONVERT_BY_SHORT_WGS(nwg_, first_, count_, excl_) do { const int rounds_ = ((nwg_) + G - 1) / G, c0_ = (nwg_) - (rounds_ - 1) * G, c1_ = G - (excl_); \
        if (bx >= c0_ && bx < c1_) { const int nw_ = (c1_ - c0_) * NWAVES; for (int it = (bx - c0_) * NWAVES + wave; it < (count_); it += nw_) CONVERT_ITEM((first_) + it); } } while (0)
    {   PHASE_IDS;
        {
            const float* xp = args.in[0]; const float* xs = args.in[1];
            for (int m = gw; m < MROWS / 2; m += NGW) { const int m2 = m + MROWS / 2;
                const float* sa = (m < MP) ? xp + (size_t)m * D : xs + (size_t)(m - MP) * D; const float* sb = (m2 < MP) ? xp + (size_t)m2 * D : xs + (size_t)(m2 - MP) * D;
                p0_row2(sa, XB + (size_t)m * D, ssq0 + (size_t)m * 4, sb, XB + (size_t)m2 * D, ssq0 + (size_t)m2 * 4, lane); }
            for (int m = gw; m < 512; m += NGW) p0_row2(args.in[7] + (size_t)m * D, (bf16*)(ws + WS_AMEM) + (size_t)m * D, ssqm + (size_t)m * 4,
                                                        args.in[7] + (size_t)(m + 512) * D, (bf16*)(ws + WS_AMEM) + (size_t)(m + 512) * D, ssqm + (size_t)(m + 512) * 4, lane);
            for (int m = MROWS + gw; m < MPAD; m += NGW) { GAS v4u* o = (GAS v4u*)(XB + (size_t)m * D) + lane; o[0] = (v4u){0u, 0u, 0u, 0u}; o[64] = (v4u){0u, 0u, 0u, 0u};
                if (lane == 0) { *(f32x4*)(ssq0 + (size_t)m * 4) = (f32x4){1024.f, 0.f, 0.f, 0.f}; } }
        }
        for (int it = gw; it < I_SET0; it += NGW) CONVERT_ITEM(it);
        for (int i = bx * 512 + tid; i < 3 * (MPAD - MP); i += G * 512) { const int k = i / (MPAD - MP), r = MP + i % (MPAD - MP); float* s = (k == 0) ? ssq1 : (k == 1) ? ssq2 : ssq3;
            *(f32x4*)(s + (size_t)r * 4) = (r < MROWS) ? (f32x4){0.f, 0.f, 0.f, 0.f} : (f32x4){1024.f, 0.f, 0.f, 0.f}; }
        for (int i = bx * 512 + tid; i < 3 * 129 * 4; i += G * 512) { const int h = i & 3, j = (i >> 2) % 129, g = (i >> 2) / 129; const int n = j << (2 * g);
            int bk = n; if (n >= 16) { bk = 16 + (int)(log((double)n / 16.0) / log(128.0) * 16.0); if (bk > 31) bk = 31; }
            ((float*)(ws + WS_BIAS))[i] = args.in[8][bk * 12 + g * 4 + h]; }
        for (int i = bx * 512 + tid; i < 3 * 4 * TAB_N; i += G * 512) { const int idx = i % TAB_N, h = (i / TAB_N) & 3, g = i / (4 * TAB_N); const int rel = 255 - idx; float v = MASKV;
            if (rel >= 0 && rel <= 128) { const int n = rel << (2 * g); int bk = n; if (n >= 16) { bk = 16 + (int)(log((double)n / 16.0) / log(128.0) * 16.0); if (bk > 31) bk = 31; }
                v = LOG2E * args.in[8][bk * 12 + g * 4 + h]; }
            ((float*)(ws + WS_BIAS2))[i] = v; }
    }
    GRID_BAR();

    {   PHASE_IDS;
        pg8::Gemm g{XB, (const bf16*)(ws + WS_W1GU), MPAD, 2 * DFF, D}; pg8::StaticOrder S; S.init(MPAD, 2 * DFF, G, bx);
        pg8::EpiGateUp E{HB, ssq0};
        pg8::gemm_phase<pg8::EpiGateUp, pg8::StaticOrder, true, true>(L, g, S, E);
        pg8::Gemm g2{(const bf16*)(ws + WS_AMEM), (const bf16*)(ws + WS_WMEM), 1024, 1024, D}; pg8::TailOrder S2{G - 16, 16, 4, bx};
        pg8::EpiMemKV E2{out + O_MKV, (bf16*)(ws + WS_MEMKV), ssqm};
        pg8::gemm_phase<pg8::EpiMemKV, pg8::TailOrder, true, true>(L, g2, S2, E2);
        CONVERT_BY_SHORT_WGS(65 * 22, I_SET0, I_SET1, 16);
    }
    GRID_BAR();

    {   PHASE_IDS;
        pg8::Gemm g{HB, (const bf16*)(ws + WS_W1D), MP, D, DFF}; pg8::StaticOrder S; S.init(MP, D, G, bx);
        pg8::EpiResid<false> E{XB, XB, ssq1, 0.5f};
        pg8::gemm_phase<pg8::EpiResid<false>, pg8::StaticOrder, false, true>(L, g, S, E);
    }
    GRID_BAR();

    {   PHASE_IDS;
        unsigned* const cs1 = (unsigned*)(ctl + CW_SMP);
        if (bx >= G - 32) { sample_resid<DFF>(L, HB + (size_t)MP * DFF, (const bf16*)(ws + WS_W1D), args.in[1], XB + (size_t)MP * D, ssq1 + (size_t)MP * 4, 0.5f, bx - (G - 32), tid, wave, lane); wg_publish(cs1, tid); }
        pg8::Gemm g{XB, (const bf16*)(ws + WS_WIN), MPAD, INCOLS, D}; pg8::GatedOrderRev S; S.init(MPAD, INCOLS, G, bx); S.cnt = cs1; S.need = 32u; S.gate_pm = 64;
        pg8::EpiWin E{(bf16*)(ws + WS_QKV), (bf16*)(ws + WS_Z), (bf16*)(ws + WS_QM), GB, ssq1, out};
        static_assert(pg8::EpiWin::o_w0p == O_W0P && pg8::EpiWin::o_pp == O_PP && pg8::EpiWin::o_w0s == O_W0S && pg8::EpiWin::o_ps == O_PS, "offsets");
        pg8::gemm_phase<pg8::EpiWin, pg8::GatedOrderRev, true, true>(L, g, S, E);
        CONVERT_BY_SHORT_WGS(65 * 25, I_SET0 + I_SET1, I_SET2, 0);
    }
    GRID_BAR();

    {   PHASE_IDS;
        {
            LAS unsigned char* vl = L + wave * 10752; LAS float* tabL = (LAS float*)(L + 86016); LAS float* xch = (LAS float*)(L + 91136) + wave * 32;
            const bf16* QKVp = (const bf16*)(ws + WS_QKV); const float* tab2 = (const float*)(ws + WS_BIAS2);
            for (int jg = vcu; jg < 256; jg += G) {
                const int J = jg * 8 + wave, b = J >> 9, hh = (J >> 7) & 3;
                __syncthreads();
                for (int i = tid; i < 3 * TAB_N + 64; i += NWAVES * 64) tabL[i] = (i < 3 * TAB_N) ? tab2[((i / TAB_N) * 4 + hh) * TAB_N + i % TAB_N] : MASKV;
                __syncthreads();
                {
                    LAS unsigned short* Ost = (LAS unsigned short*)(L + 92160); LAS float* Mst = (LAS float*)(L + 124928); LAS float* Lst = (LAS float*)(L + 125952);
                    const int u = jg & 15, sp = u >> 1, c0 = 2 * (u & 1);
                    attn_g2_job(QKVp, Ost, Mst, Lst, b, hh, c0 + (wave >> 2) + 4 * (wave & 3), sp, c0, vl, tabL, xch, lane);
                    __syncthreads();
                    attn_g01_job(QKVp, Ost, Mst, Lst, (bf16*)(ws + WS_ABC), b, hh, 4 * sp + (wave & 3), c0 + (wave >> 2), sp, c0, vl, tabL, xch, lane);
                }
                memattn_wg((const bf16*)(ws + WS_QM), (const bf16*)(ws + WS_MEMKV), (bf16*)(ws + WS_ABC) + 768, b, hh, J & 127, L, xch, tid, lane);
                __syncthreads();
                if (bx >= 128 || G != 256) { pool_job((const bf16*)(ws + WS_Z), (const bf16*)(ws + WS_WPOOL), args.in[16], (bf16*)(ws + WS_ABC) + 256, 32 * (J >> 2), J & 3, vl, lane);
                    if (G == 256) { const int J2 = J - 128; __syncthreads(); pool_job((const bf16*)(ws + WS_Z), (const bf16*)(ws + WS_WPOOL), args.in[16], (bf16*)(ws + WS_ABC) + 256, 32 * (J2 >> 2), J2 & 3, vl, lane); } }
            }
        }
        {
            LAS float* sx = (LAS float*)(L + 94208); LAS unsigned char* ptile = L + 102400;
            const int sp = bx - 128, ss = sp >> 2, sh = sp & 3;
            if (bx >= 128 && bx < 256) {
                if (wave < 3) sample_attn_group((const bf16*)(ws + WS_QKV) + (size_t)(MP + ss) * 2304, args.in[2 + wave], (const float*)(ws + WS_BIAS), ss, sh, wave, sx, lane);
                else if (wave < 7) sample_mem_quarter((const bf16*)(ws + WS_QM) + (size_t)(MP + ss) * 512, args.in[6], ss, sh, wave - 3, sx, lane);
            } else if (bx < 4) sample_pool_fill((const bf16*)(ws + WS_Z) + (size_t)MP * 512, args.in[5], bx, ptile, wave, lane);
            __syncthreads();
            if (bx >= 128 && bx < 256) sample_combine((bf16*)(ws + WS_ABC) + (size_t)(MP + ss) * KCAT, (bf16*)(ws + WS_ABC) + (size_t)(MP + ss) * KCAT + 768, sh, sx, wave, lane);
            else if (bx < 4 && wave == 0) pool_mma(ptile, (const bf16*)(ws + WS_WPOOL), args.in[16], (bf16*)(ws + WS_ABC) + 256, MP, bx, lane);
        }
    }
    GRID_BAR();

    {   PHASE_IDS;
        pg8::StaticOrder S; S.init(MP, D, G, bx);
        { pg8::Gemm g{(const bf16*)(ws + WS_ABC), (const bf16*)(ws + WS_WOA), MP, D, KCAT}; pg8::EpiMergeH E{GB, MB}; pg8::gemm_phase<pg8::EpiMergeH, pg8::StaticOrder, false, true>(L, g, S, E); }
    }
    GRID_BAR();

    {   PHASE_IDS;
        pg8::Gemm g{MB, (const bf16*)(ws + WS_WOUT), MP, D, D}; pg8::StaticOrder S; S.init(MP, D, G, bx);
        pg8::EpiResid<false> E{XB, XB, ssq2, 1.0f};
        pg8::gemm_phase<pg8::EpiResid<false>, pg8::StaticOrder, false, true>(L, g, S, E);
    }
    GRID_BAR();

    {   PHASE_IDS;
        unsigned* const cs2 = (unsigned*)(ctl + CW_SMP + 64); unsigned* const cs3 = (unsigned*)(ctl + CW_SMP + 128);
        if (bx >= G - 32) { const int ct = bx - (G - 32);
            float mv[2] = {0.f, 0.f};
            { mini_gemm32<256>(L, (const bf16*)(ws + WS_ABC) + (size_t)MP * KCAT, (const bf16*)(ws + WS_WOA), 32 * ct, wave, lane, KCAT, KCAT);
#pragma unroll
              for (int i = 0; i < 2; ++i) { int row, col; const float v = mini_elem(L, tid, i, row, col); mv[i] += (float)GB[(size_t)(MP + row) * 3072 + 32 * ct + col] * (1.0f / 255.0f) * v; }
              __syncthreads(); }
#pragma unroll
            for (int b = 1; b < 3; ++b) { const int ko = (b == 1) ? 256 : 768;
                mini_gemm32<512>(L, (const bf16*)(ws + WS_ABC) + (size_t)MP * KCAT + ko, (const bf16*)(ws + WS_WOA) + ko, 32 * ct, wave, lane, KCAT, KCAT);
#pragma unroll
                for (int i = 0; i < 2; ++i) { int row, col; const float v = mini_elem(L, tid, i, row, col); mv[i] += (float)GB[(size_t)(MP + row) * 3072 + b * 1024 + 32 * ct + col] * (1.0f / 255.0f) * v; }
                __syncthreads(); }
#pragma unroll
            for (int i = 0; i < 2; ++i) { const int r = (tid >> 6) + 8 * i, l = tid & 63, row = (r & 3) + 8 * (r >> 2) + 4 * (l >> 5), col = l & 31; MB[(size_t)(MP + row) * 1024 + 32 * ct + col] = (bf16)f2bf(mv[i]); }
            wg_publish(cs2, tid); wg_wait(cs2, 32u, tid);
            sample_resid<D>(L, MB + (size_t)MP * D, (const bf16*)(ws + WS_WOUT), nullptr, XB + (size_t)MP * D, ssq2 + (size_t)MP * 4, 1.0f, ct, tid, wave, lane);
            wg_publish(cs3, tid);
        }
        pg8::Gemm g{XB, (const bf16*)(ws + WS_W2GU), MPAD, 2 * DFF, D}; pg8::GatedOrder S; S.init(MPAD, 2 * DFF, G, bx); S.cnt = cs3; S.need = 32u; S.gate_pm = 64;
        pg8::EpiGateUp E{HB, ssq2};
        pg8::gemm_phase<pg8::EpiGateUp, pg8::GatedOrder, true, true>(L, g, S, E);
    }
    GRID_BAR();

    {   PHASE_IDS;
        pg8::Gemm g{HB, (const bf16*)(ws + WS_W2D), MP, D, DFF}; pg8::StaticOrder S; S.init(MP, D, G, bx);
        pg8::EpiFinal E{XB, out, args.in[27], ssq3, (unsigned*)(ctl + CW_FIN), 0.5f};
        pg8::gemm_phase<pg8::EpiFinal, pg8::StaticOrder, false, true>(L, g, S, E);
        if (bx < 32) sample_final<DFF>(L, HB + (size_t)MP * DFF, (const bf16*)(ws + WS_W2D), XB + (size_t)MP * D, out + (size_t)MP * D, args.in[27], ssq3 + (size_t)MP * 4, (unsigned*)(ctl + CW_FINS), 0.5f, bx, tid, wave, lane);
    }
}

extern "C" void kernel_launch(void* const* d_in, const int* in_sizes, int n_in, void* d_out, int out_size, void* d_ws, size_t ws_size, hipStream_t stream) {
    static int grid = 0;
    if (grid == 0) {
        if (n_in != 28 || out_size != (int)O_END || ws_size < WS_END) { fprintf(stderr, "kernel_launch: unexpected shapes: n_in %d out %d (want %zu) ws %zu (want %zu)\n", n_in, out_size, (size_t)O_END, ws_size, (size_t)WS_END); grid = -1; return; }
        int dev = 0, cus = 0;
        if (hipGetDevice(&dev) != hipSuccess || hipDeviceGetAttribute(&cus, hipDeviceAttributeMultiprocessorCount, dev) != hipSuccess) { grid = -1; return; }
        if (hipFuncSetAttribute((const void*)fwd_kernel, hipFuncAttributeMaxDynamicSharedMemorySize, LDS_BYTES) != hipSuccess) { fprintf(stderr, "kernel_launch: hipFuncSetAttribute failed\n"); grid = -1; return; }
        int per_cu = 0;
        if (hipOccupancyMaxActiveBlocksPerMultiprocessor(&per_cu, (const void*)fwd_kernel, NWAVES * 64, LDS_BYTES) != hipSuccess || per_cu < 1) fprintf(stderr, "kernel_launch: occupancy query reports %d\n", per_cu);
        (void)hipGetLastError();
        grid = cus;
        if (grid != 256) fprintf(stderr, "kernel_launch: built for 256 CUs, device has %d\n", grid);
    }
    if (grid < 0) return;
    if (hipMemsetAsync((char*)d_ws + WS_CTL, 0, CTL_ZERO_BYTES, stream) != hipSuccess) return;
    Args a{};
    for (int i = 0; i < 28; ++i) a.in[i] = (const float*)d_in[i];
    a.out = (float*)d_out; a.ws = (unsigned char*)d_ws;
    hipLaunchKernelGGL(fwd_kernel, dim3(grid), dim3(NWAVES * 64), LDS_BYTES, stream, a);
}
```
